# Optimizing an MI355X kernel written in HIP

```python
import math
import jax, jax.numpy as jnp
from jax import lax
import numpy as np


D_MODEL = 2048
BATCH = 4
SEQ = 8192
DEPTH = 2

GRID_W = 64
HEAD_DIM = 128
N_HEADS = D_MODEL // HEAD_DIM
N_KV_HEADS = N_HEADS // 4
GQA_GROUP = N_HEADS // N_KV_HEADS
ATTN_WIDTH = N_HEADS * HEAD_DIM
KV_WIDTH = N_KV_HEADS * HEAD_DIM
ATTN_IN_WIDTH = ATTN_WIDTH + 2 * KV_WIDTH + ATTN_WIDTH
ROPE_AXIS_DIM = HEAD_DIM // 2
ROPE_THETA = 10000.0
Q_BLOCK = 128
FOURIER_WIDTH = D_MODEL
FOURIER_GROUPS = 8
FOURIER_GROUP_W = FOURIER_WIDTH // FOURIER_GROUPS
FOURIER_IN_WIDTH = 2 * FOURIER_WIDTH
N_MIXERS = 2
N_ATTN_LAYERS = (DEPTH + 1) // 2
N_FOURIER_LAYERS = DEPTH // 2
EPS = 1e-6

kernel_name = "hybrid_gqa_axial_rope_fnet_adaln_encoder"


def rms_norm(x, gain):
    x32 = x.astype(jnp.float32)
    y = x32 * lax.rsqrt(jnp.mean(x32 * x32, axis=-1, keepdims=True) + EPS)
    return y.astype(x.dtype) * gain


def axial_rope_tables(seq_len):
    rows = seq_len // GRID_W
    row_ids = jnp.repeat(jnp.arange(rows), GRID_W).astype(jnp.float32)
    col_ids = jnp.tile(jnp.arange(GRID_W), rows).astype(jnp.float32)
    inv_freq = ROPE_THETA ** (-jnp.arange(0, ROPE_AXIS_DIM, 2, dtype=jnp.float32) / ROPE_AXIS_DIM)
    ang = jnp.concatenate([row_ids[:, None] * inv_freq[None, :],
                           col_ids[:, None] * inv_freq[None, :]], axis=-1)
    return jnp.cos(ang), jnp.sin(ang)


def apply_rope(x, cos, sin):
    xf = x.astype(jnp.float32).reshape(*x.shape[:-1], HEAD_DIM // 2, 2)
    x1, x2 = xf[..., 0], xf[..., 1]
    c = cos[None, :, None, :]
    s = sin[None, :, None, :]
    out = jnp.stack([x1 * c - x2 * s, x1 * s + x2 * c], axis=-1)
    return out.reshape(x.shape).astype(x.dtype)


def attention_mixer(h, w_in, q_gain, k_gain, w_out):
    B, S, _ = h.shape
    proj = h @ w_in
    q = proj[..., :ATTN_WIDTH].reshape(B, S, N_HEADS, HEAD_DIM)
    k = proj[..., ATTN_WIDTH:ATTN_WIDTH + KV_WIDTH].reshape(B, S, N_KV_HEADS, HEAD_DIM)
    v = proj[..., ATTN_WIDTH + KV_WIDTH:ATTN_WIDTH + 2 * KV_WIDTH].reshape(B, S, N_KV_HEADS, HEAD_DIM)
    gate = proj[..., ATTN_WIDTH + 2 * KV_WIDTH:]
    q = rms_norm(q, q_gain)
    k = rms_norm(k, k_gain)
    cos, sin = axial_rope_tables(S)
    q = apply_rope(q, cos, sin)
    k = apply_rope(k, cos, sin)
    scale = 1.0 / math.sqrt(HEAD_DIM)
    k32 = k.astype(jnp.float32)
    n_blocks = S // Q_BLOCK
    qb = q.reshape(B, n_blocks, Q_BLOCK, N_KV_HEADS, GQA_GROUP, HEAD_DIM).transpose(1, 0, 2, 3, 4, 5)

    def attend(q_blk):
        s = jnp.einsum('bqkgd,bskd->bkgqs', q_blk.astype(jnp.float32), k32) * scale
        p = jax.nn.softmax(s, axis=-1)
        return jnp.einsum('bkgqs,bskd->bqkgd', p.astype(v.dtype), v)

    o = lax.map(attend, qb)
    o = o.transpose(1, 0, 2, 3, 4, 5).reshape(B, S, ATTN_WIDTH)
    return (o * jax.nn.silu(gate)) @ w_out


def fourier_mixer(h, w_in, w_out):
    B, S, _ = h.shape
    proj = h @ w_in
    u = proj[..., :FOURIER_WIDTH]
    gate = proj[..., FOURIER_WIDTH:]
    ug = u.astype(jnp.float32).reshape(B, S, FOURIER_GROUPS, FOURIER_GROUP_W)
    f = jnp.fft.fft2(ug, axes=(1, 3), norm="ortho").real
    f = f.reshape(B, S, FOURIER_WIDTH).astype(h.dtype)
    return (f * jax.nn.silu(gate)) @ w_out


def setup_inputs(seed: int = 0) -> dict:
    key = jax.random.key(seed)
    ks = jax.random.split(key, 12)
    f32 = jnp.float32
    D = D_MODEL
    x = jax.random.normal(ks[0], (BATCH, SEQ, D), f32)
    c = jax.random.normal(ks[1], (BATCH, D), f32)
    norm_g = 1.0 + 0.02 * jax.random.normal(ks[2], (DEPTH, D), f32)
    ada_w = jax.random.normal(ks[3], (DEPTH, D, 3 * D), f32) * D ** -0.5
    ada_b = 0.02 * jax.random.normal(ks[4], (DEPTH, 3 * D), f32)
    attn_w_in = jax.random.normal(ks[5], (N_ATTN_LAYERS, D, ATTN_IN_WIDTH), f32) * D ** -0.5
    attn_q_gain = 1.0 + 0.02 * jax.random.normal(ks[6], (N_ATTN_LAYERS, HEAD_DIM), f32)
    attn_k_gain = 1.0 + 0.02 * jax.random.normal(ks[7], (N_ATTN_LAYERS, HEAD_DIM), f32)
    attn_w_out = jax.random.normal(ks[8], (N_ATTN_LAYERS, ATTN_WIDTH, D), f32) * ATTN_WIDTH ** -0.5
    fourier_w_in = jax.random.normal(ks[9], (N_FOURIER_LAYERS, D, FOURIER_IN_WIDTH), f32) * D ** -0.5
    fourier_w_out = jax.random.normal(ks[10], (N_FOURIER_LAYERS, FOURIER_WIDTH, D), f32) * FOURIER_WIDTH ** -0.5
    final_g = 1.0 + 0.02 * jax.random.normal(ks[11], (D,), f32)
    return {"x": x, "c": c, "norm_g": norm_g, "ada_w": ada_w, "ada_b": ada_b,
            "attn_w_in": attn_w_in, "attn_q_gain": attn_q_gain, "attn_k_gain": attn_k_gain,
            "attn_w_out": attn_w_out, "fourier_w_in": fourier_w_in, "fourier_w_out": fourier_w_out,
            "final_g": final_g}


def reference(x, c, norm_g, ada_w, ada_b, attn_w_in, attn_q_gain, attn_k_gain,
              attn_w_out, fourier_w_in, fourier_w_out, final_g):
    D = D_MODEL
    c_act = jax.nn.silu(c)
    for i in range(DEPTH):
        mod = c_act @ ada_w[i] + ada_b[i]
        shift = mod[:, None, :D]
        scale = mod[:, None, D:2 * D]
        gate = mod[:, None, 2 * D:]
        h = rms_norm(x, norm_g[i]) * (1.0 + scale) + shift
        j = i // N_MIXERS
        if i % N_MIXERS == 0:
            y = attention_mixer(h, attn_w_in[j], attn_q_gain[j], attn_k_gain[j], attn_w_out[j])
        else:
            y = fourier_mixer(h, fourier_w_in[j], fourier_w_out[j])
        x = x + gate * y
    return rms_norm(x, final_g)
```

```cpp
#include <hip/hip_runtime.h>
#include <hip/hip_cooperative_groups.h>
#include <cstdio>
#include <cstdint>
namespace cg = cooperative_groups;

__device__ __forceinline__ unsigned short f2bf_rne(float f) { unsigned u = __builtin_bit_cast(unsigned, f); return (unsigned short)((u + 0x7fffu + ((u >> 16) & 1u)) >> 16); }
__device__ __forceinline__ float bf2f(unsigned short h) { return __builtin_bit_cast(float, (unsigned)h << 16); }
__device__ __forceinline__ int lane_id() { return (int)__builtin_amdgcn_mbcnt_hi(~0u, __builtin_amdgcn_mbcnt_lo(~0u, 0u)); }
__device__ __forceinline__ float silu_f(float g) { return g * __builtin_amdgcn_rcpf(1.f + __expf(-g)); }

namespace pg8 {
#define PG8_LAS __attribute__((address_space(3)))
typedef unsigned short bf16_t;
typedef short bf16x8 __attribute__((ext_vector_type(8)));
typedef float f32x4 __attribute__((ext_vector_type(4)));
typedef unsigned u32x4 __attribute__((ext_vector_type(4)));
typedef unsigned u32x2 __attribute__((ext_vector_type(2)));
constexpr int BM = 256, BK = 64, HALF = 128, HTB = HALF * BK * 2  , STAGE_BYTES = 8 * HTB, NXCD = 8, WGM = 4;

__host__ __device__ __forceinline__ int lds_byte(int r, int c) { const int st = (r >> 4) * 2 + (c >> 5), rr = r & 15, cc = c & 31, ob = rr * 64 + cc * 2; return st * 1024 + (ob ^ (((ob >> 9) & 1) << 5)); }
__host__ __device__ __forceinline__ void stage_rc(int b, int& R, int& C) { const int st = b / 1024, sb = b % 1024, swz = sb ^ (((sb >> 9) & 1) << 5); R = (st >> 1) * 16 + swz / 64; C = (st & 1) * 32 + (swz % 64) / 2; }
__host__ __device__ __forceinline__ int perm32(int rho) { const int n = rho >> 4, i = rho & 15; return 8 * (i >> 2) + 4 * n + (i & 3); }

struct Unit { int pm, pn; };
struct Gemm { const bf16_t* A; const bf16_t* Bt; int lda, ldb, K; size_t a_pn_off, b_pn_step; };

struct StaticOrder {
    int nM, nN, nwg, G, c;
    __host__ __device__ void init(int M, int N, int G_, int c_) { nM = M / BM; nN = N / BM; nwg = nM * nN; G = G_; c = c_; }
    __host__ __device__ bool next(int i, Unit& u) const {
        const long L = (long)i * G + c; if (L >= nwg) return false;
        int wgid = (int)L; { const int q = nwg / NXCD, r = nwg % NXCD, xcd = wgid % NXCD, off = wgid / NXCD; wgid = (xcd < r ? xcd * (q + 1) : r * (q + 1) + (xcd - r) * q) + off; }
        const int nig = WGM * nN, gid = wgid / nig, fm = gid * WGM, gsz = (nM - fm) < WGM ? (nM - fm) : WGM;
        u.pm = fm + ((wgid % nig) % gsz); u.pn = (wgid % nig) / gsz; return true;
    }
    __device__ __forceinline__ void a_ready(const Unit&) const {}
    __device__ __forceinline__ void done(const Unit&) const {}
};

struct DualOrder {
    StaticOrder S1, S2; int n1, a1, b1, a2, b2;
    __host__ __device__ void init(int M1, int N1, int M2, int N2, int G, int c, int a1_, int b1_, int a2_, int b2_) {
        S1.init(M1, N1, G, c); S2.init(M2, N2, G, c); n1 = (c < S1.nwg) ? (S1.nwg - c + G - 1) / G : 0; a1 = a1_; b1 = b1_; a2 = a2_; b2 = b2_; }
    __host__ __device__ bool next(int i, Unit& u) const {
        if (i < n1) { if (!S1.next(i, u)) return false; u.pm += a1; u.pn += b1; return true; }
        if (!S2.next(i - n1, u)) return false; u.pm += a2; u.pn += b2; return true; }
    __device__ __forceinline__ void a_ready(const Unit&) const {}
    __device__ __forceinline__ void done(const Unit&) const {}
};

__device__ __forceinline__ unsigned cvt_pk_bf16(float lo, float hi) { unsigned r; asm volatile("v_cvt_pk_bf16_f32 %0, %1, %2" : "=v"(r) : "v"(lo), "v"(hi)); return r; }
__device__ __forceinline__ u32x4 pack8(f32x4 v0, f32x4 v1) { u32x4 w; w.x = cvt_pk_bf16(v0[0], v0[1]); w.y = cvt_pk_bf16(v0[2], v0[3]); w.z = cvt_pk_bf16(v1[0], v1[1]); w.w = cvt_pk_bf16(v1[2], v1[3]); return w; }
__device__ __forceinline__ float silu1(float g) { return g * __builtin_amdgcn_rcpf(1.f + __expf(-g)); }
__device__ __forceinline__ f32x4 silu4(f32x4 v) { return (f32x4){silu1(v[0]), silu1(v[1]), silu1(v[2]), silu1(v[3])}; }
__device__ __forceinline__ float bfl(unsigned w) { return __builtin_bit_cast(float, w << 16); }
__device__ __forceinline__ float bfh(unsigned w) { return __builtin_bit_cast(float, w & 0xffff0000u); }

struct EpiPlain {
    static constexpr bool PERM = true, AFTER_DRAIN = false;
    bf16_t* O; int ldc;
    __device__ __forceinline__ void operator()(const f32x4 (&acc)[2][2][4][2], const Unit& u, int wr, int wc, int fr, int fq) const {
        const int row0 = u.pm * BM + wr * 64 + fr, col0 = u.pn * BM + wc * 32 + 8 * fq;
#pragma unroll
        for (int ai = 0; ai < 2; ++ai)
#pragma unroll
            for (int m = 0; m < 4; ++m) { bf16_t* rowp = O + (size_t)(row0 + ai * HALF + m * 16) * ldc + col0;
#pragma unroll
                for (int bj = 0; bj < 2; ++bj) *(u32x4*)(rowp + bj * HALF) = pack8(acc[ai][bj][m][0], acc[ai][bj][m][1]); }
    }
};
struct EpiQKVG {
    static constexpr bool PERM = true, AFTER_DRAIN = false;
    bf16_t* O; bf16_t* KC; bf16_t* VC; const float* kg; PG8_LAS float* scr;
    __device__ __forceinline__ void operator()(const f32x4 (&acc)[2][2][4][2], const Unit& u, int wr, int wc, int fr, int fq) const {
        const int rl0 = wr * 64 + fr, colw = wc * 32 + 8 * fq;
        if (u.pn < 8 || u.pn >= 12) {
            const int row0 = u.pm * BM + rl0, col0 = u.pn * BM + colw;
#pragma unroll
            for (int ai = 0; ai < 2; ++ai)
#pragma unroll
                for (int m = 0; m < 4; ++m) { bf16_t* rowp = O + (size_t)(row0 + ai * HALF + m * 16) * 5120 + col0;
#pragma unroll
                    for (int bj = 0; bj < 2; ++bj) *(u32x4*)(rowp + bj * HALF) = pack8(acc[ai][bj][m][0], acc[ai][bj][m][1]); }
            return;
        }
        const int b = u.pm >> 5, t0 = (u.pm & 31) * BM + rl0;
        if (u.pn >= 10) {
            const int h0 = (u.pn - 10) * 2;
#pragma unroll
            for (int ai = 0; ai < 2; ++ai)
#pragma unroll
                for (int m = 0; m < 4; ++m)
#pragma unroll
                    for (int bj = 0; bj < 2; ++bj)
                        *(u32x4*)(VC + (((size_t)(b * 4 + h0 + bj)) * 8192 + t0 + ai * HALF + m * 16) * 128 + colw) = pack8(acc[ai][bj][m][0], acc[ai][bj][m][1]);
            return;
        }
        const int h0 = (u.pn - 8) * 2;
#pragma unroll
        for (int ai = 0; ai < 2; ++ai)
#pragma unroll
            for (int m = 0; m < 4; ++m)
#pragma unroll
                for (int bj = 0; bj < 2; ++bj) { const f32x4 a = acc[ai][bj][m][0], c = acc[ai][bj][m][1];
                    float ss = (a[0] * a[0] + a[1] * a[1]) + (a[2] * a[2] + a[3] * a[3]) + (c[0] * c[0] + c[1] * c[1]) + (c[2] * c[2] + c[3] * c[3]);
                    ss += __builtin_bit_cast(float, __builtin_amdgcn_ds_swizzle(__builtin_bit_cast(int, ss), (16 << 10) | 0x1f));
                    { float x = ss, y = ss; asm volatile("s_nop 1\n\tv_permlane32_swap_b32 %0, %1\n\ts_nop 1" : "+v"(x), "+v"(y)); ss = x + y; }
                    if (fq == 0) scr[((wc * 256 + ai * HALF + m * 16 + rl0) * 2) + bj] = ss; }
        asm volatile("s_waitcnt lgkmcnt(0)" ::: "memory"); __builtin_amdgcn_s_barrier();
        float rstd[2][4][2];
#pragma unroll
        for (int ai = 0; ai < 2; ++ai)
#pragma unroll
            for (int m = 0; m < 4; ++m) { const int r = ai * HALF + m * 16 + rl0;
                typedef float f32x2_t __attribute__((ext_vector_type(2)));
                const f32x2_t s0 = *(const PG8_LAS f32x2_t*)(scr + (0 * 256 + r) * 2), s1 = *(const PG8_LAS f32x2_t*)(scr + (1 * 256 + r) * 2),
                              s2 = *(const PG8_LAS f32x2_t*)(scr + (2 * 256 + r) * 2), s3 = *(const PG8_LAS f32x2_t*)(scr + (3 * 256 + r) * 2);
                rstd[ai][m][0] = __builtin_amdgcn_rsqf(((s0.x + s1.x) + (s2.x + s3.x)) * (1.f / 128.f) + 1e-6f);
                rstd[ai][m][1] = __builtin_amdgcn_rsqf(((s0.y + s1.y) + (s2.y + s3.y)) * (1.f / 128.f) + 1e-6f); }
        asm volatile("s_waitcnt lgkmcnt(0)" ::: "memory"); __builtin_amdgcn_s_barrier();
        const f32x4 g0 = *(const f32x4*)(kg + colw), g1 = *(const f32x4*)(kg + colw + 4);
        float invf[4];
#pragma unroll
        for (int q = 0; q < 4; ++q) invf[q] = exp2f(-(float)(16 * (wc & 1) + 4 * fq + q) * (13.287712379549449f / 32.f)) * 0.15915494309189535f;
#pragma unroll
        for (int ai = 0; ai < 2; ++ai)
#pragma unroll
            for (int m = 0; m < 4; ++m) { int t = t0 + ai * HALF + m * 16; asm volatile("" : "+v"(t));
                const float pos = (float)((wc < 2) ? (t >> 6) : (t & 63));
                float cs[4], sn[4];
#pragma unroll
                for (int q = 0; q < 4; ++q) { float xr = pos * invf[q]; xr -= floorf(xr); cs[q] = __builtin_amdgcn_cosf(xr); sn[q] = __builtin_amdgcn_sinf(xr); }
#pragma unroll
                for (int bj = 0; bj < 2; ++bj) { const f32x4 y0 = acc[ai][bj][m][0] * rstd[ai][m][bj] * g0, y1 = acc[ai][bj][m][1] * rstd[ai][m][bj] * g1;
                    u32x4 w;
                    w.x = cvt_pk_bf16(y0[0] * cs[0] - y0[1] * sn[0], y0[0] * sn[0] + y0[1] * cs[0]);
                    w.y = cvt_pk_bf16(y0[2] * cs[1] - y0[3] * sn[1], y0[2] * sn[1] + y0[3] * cs[1]);
                    w.z = cvt_pk_bf16(y1[0] * cs[2] - y1[1] * sn[2], y1[0] * sn[2] + y1[1] * cs[2]);
                    w.w = cvt_pk_bf16(y1[2] * cs[3] - y1[3] * sn[3], y1[2] * sn[3] + y1[3] * cs[3]);
                    *(u32x4*)(KC + (((size_t)(b * 4 + h0 + bj)) * 8192 + t) * 128 + colw) = w; }
                __builtin_amdgcn_sched_barrier(0); }
    }
};
struct EpiUT {
    static constexpr bool PERM = true, AFTER_DRAIN = false;
    bf16_t* UT;
    __device__ __forceinline__ void operator()(const f32x4 (&acc)[2][2][4][2], const Unit& u, int wr, int wc, int fr, int fq) const {
        const int b = u.pn >> 5, p0 = (u.pn & 31) * BM + wc * 32 + 8 * fq, c0 = u.pm * BM + wr * 64 + fr;
#pragma unroll
        for (int ai = 0; ai < 2; ++ai)
#pragma unroll
            for (int m = 0; m < 4; ++m) { bf16_t* rowp = UT + ((size_t)(b * 2048 + c0 + ai * HALF + m * 16)) * 8192 + p0;
#pragma unroll
                for (int bj = 0; bj < 2; ++bj) *(u32x4*)(rowp + bj * HALF) = pack8(acc[ai][bj][m][0], acc[ai][bj][m][1]); }
    }
};
struct EpiSGperm {
    static constexpr bool PERM = true, AFTER_DRAIN = false;
    bf16_t* SG;
    __device__ __forceinline__ void operator()(const f32x4 (&acc)[2][2][4][2], const Unit& u, int wr, int wc, int fr, int fq) const {
        const int b = u.pm >> 5, p0 = (u.pm & 31) * BM + wr * 64 + fr, col0 = u.pn * BM + wc * 32 + 8 * fq;
#pragma unroll
        for (int ai = 0; ai < 2; ++ai)
#pragma unroll
            for (int m = 0; m < 4; ++m) { const int p = p0 + ai * HALF + m * 16, n = (p & 127) * 64 + (p >> 7);
                bf16_t* rowp = SG + (size_t)(b * 8192 + n) * 2048 + col0;
#pragma unroll
                for (int bj = 0; bj < 2; ++bj) *(u32x4*)(rowp + bj * HALF) = pack8(silu4(acc[ai][bj][m][0]), silu4(acc[ai][bj][m][1])); }
    }
};
struct EpiUTSG {
    static constexpr bool PERM = true, AFTER_DRAIN = false;
    EpiUT E1; EpiSGperm E2;
    __device__ __forceinline__ void operator()(const f32x4 (&acc)[2][2][4][2], const Unit& u, int wr, int wc, int fr, int fq) const {
        if (u.pm < 320) { const Unit v{u.pm - 28, u.pn - 320}; E1(acc, v, wr, wc, fr, fq); }
        else            { const Unit v{u.pm - 320, u.pn - 36}; E2(acc, v, wr, wc, fr, fq); }
    }
};
struct EpiResid1 {
    static constexpr bool PERM = true, AFTER_DRAIN = false;
    const float* res; bf16_t* out; const float* gate;
    __device__ __forceinline__ void operator()(const f32x4 (&acc)[2][2][4][2], const Unit& u, int wr, int wc, int fr, int fq) const {
        const int row0 = u.pm * BM + wr * 64 + fr, col0 = u.pn * BM + wc * 32 + 8 * fq;
        const float* gb = gate + (size_t)(u.pm / 32) * 6144 + col0;
        f32x4 gv[2][2];
#pragma unroll
        for (int bj = 0; bj < 2; ++bj)
#pragma unroll
            for (int n = 0; n < 2; ++n) gv[bj][n] = *(const f32x4*)(gb + bj * HALF + 4 * n);
#pragma unroll
        for (int ai = 0; ai < 2; ++ai)
#pragma unroll
            for (int m = 0; m < 4; ++m) { const size_t off = (size_t)(row0 + ai * HALF + m * 16) * 2048 + col0;
#pragma unroll
                for (int bj = 0; bj < 2; ++bj) { const f32x4 x0 = *(const f32x4*)(res + off + bj * HALF), x1 = *(const f32x4*)(res + off + bj * HALF + 4);
                    *(u32x4*)(out + off + bj * HALF) = pack8(x0 + gv[bj][0] * acc[ai][bj][m][0], x1 + gv[bj][1] * acc[ai][bj][m][1]); } }
    }
};
struct EpiResid2 {
    static constexpr bool PERM = true, AFTER_DRAIN = false;
    bf16_t* xio; const float* gate;
    __device__ __forceinline__ void operator()(const f32x4 (&acc)[2][2][4][2], const Unit& u, int wr, int wc, int fr, int fq) const {
        const int row0 = u.pm * BM + wr * 64 + fr, col0 = u.pn * BM + wc * 32 + 8 * fq;
        const float* gb = gate + (size_t)(u.pm / 32) * 6144 + col0;
        f32x4 gv[2][2];
#pragma unroll
        for (int bj = 0; bj < 2; ++bj)
#pragma unroll
            for (int n = 0; n < 2; ++n) gv[bj][n] = *(const f32x4*)(gb + bj * HALF + 4 * n);
#pragma unroll
        for (int ai = 0; ai < 2; ++ai)
#pragma unroll
            for (int m = 0; m < 4; ++m) { const size_t off = (size_t)(row0 + ai * HALF + m * 16) * 2048 + col0;
#pragma unroll
                for (int bj = 0; bj < 2; ++bj) { const u32x4 s = *(const u32x4*)(xio + off + bj * HALF);
                    const f32x4 x0 = {bfl(s.x), bfh(s.x), bfl(s.y), bfh(s.y)}, x1 = {bfl(s.z), bfh(s.z), bfl(s.w), bfh(s.w)};
                    *(u32x4*)(xio + off + bj * HALF) = pack8(x0 + gv[bj][0] * acc[ai][bj][m][0], x1 + gv[bj][1] * acc[ai][bj][m][1]); } }
    }
};
struct EpiFft1 {
    static constexpr bool PERM = true, AFTER_DRAIN = false;
    bf16_t* T;
    __device__ __forceinline__ void operator()(const f32x4 (&acc)[2][2][4][2], const Unit& u, int wr, int wc, int fr, int fq) const {
        const int b = u.pn >> 9, c0 = (u.pn & 511) * 4 + (wc >> 1), n2b = 32 * (wc & 1) + 8 * fq;
#pragma unroll
        for (int m = 0; m < 4; ++m) { int k1 = wr * 64 + m * 16 + fr; asm volatile("" : "+v"(k1));
            bf16_t* p = T + (((size_t)(b * 128 + k1)) * 2048 + c0) * 128 + n2b;
            f32x4 cv[2], sv[2];
#pragma unroll
            for (int n = 0; n < 2; ++n)
#pragma unroll
                for (int j = 0; j < 4; ++j) { const float xr = (float)(((n2b + 4 * n + j) * k1) & 8191) * (1.f / 8192.f); cv[n][j] = __builtin_amdgcn_cosf(xr); sv[n][j] = __builtin_amdgcn_sinf(xr); }
#pragma unroll
            for (int bj = 0; bj < 2; ++bj) { const f32x4 r0 = acc[0][bj][m][0], r1 = acc[0][bj][m][1], i0 = acc[1][bj][m][0], i1 = acc[1][bj][m][1];
                *(u32x4*)(p + bj * 256) = pack8(r0 * cv[0] + i0 * sv[0], r1 * cv[1] + i1 * sv[1]);
                *(u32x4*)(p + bj * 256 + 64) = pack8(i0 * cv[0] - r0 * sv[0], i1 * cv[1] - r1 * sv[1]); }
            __builtin_amdgcn_sched_barrier(0); }
    }
};
struct EpiFft2 {
    static constexpr bool PERM = true, AFTER_DRAIN = false;
    bf16_t* Z;
    __device__ __forceinline__ void operator()(const f32x4 (&acc)[2][2][4][2], const Unit& u, int wr, int wc, int fr, int fq) const {
        const int b = u.pn >> 10, k1 = (u.pn >> 3) & 127, g = u.pn & 7;
        const int col0 = g * 512 + wr * 256 + wc * 32 + 8 * fq;
#pragma unroll
        for (int m = 0; m < 4; ++m) { const int k2 = m * 16 + fr; bf16_t* rowp = Z + (size_t)(b * 8192 + k1 + 128 * k2) * 4096 + col0;
#pragma unroll
            for (int bj = 0; bj < 2; ++bj) *(u32x4*)(rowp + bj * HALF) = pack8(acc[0][bj][m][0], acc[0][bj][m][1]); }
    }
};
struct EpiDftC {
    static constexpr bool PERM = true, AFTER_DRAIN = false;
    const bf16_t* SG; bf16_t* FG; float norm;
    __device__ __forceinline__ void operator()(const f32x4 (&acc)[2][2][4][2], const Unit& u, int wr, int wc, int fr, int fq) const {
        const int row0 = u.pm * BM + wr * 64 + fr, col0 = u.pn * BM + wc * 32 + 8 * fq;
#pragma unroll
        for (int ai = 0; ai < 2; ++ai)
#pragma unroll
            for (int m = 0; m < 4; ++m) { const size_t off = (size_t)(row0 + ai * HALF + m * 16) * 2048 + col0;
#pragma unroll
                for (int bj = 0; bj < 2; ++bj) { const u32x4 s = *(const u32x4*)(SG + off + bj * HALF);
                    f32x4 v0 = acc[ai][bj][m][0] * norm, v1 = acc[ai][bj][m][1] * norm;
                    v0 = v0 * (f32x4){bfl(s.x), bfh(s.x), bfl(s.y), bfh(s.y)}; v1 = v1 * (f32x4){bfl(s.z), bfh(s.z), bfl(s.w), bfh(s.w)};
                    *(u32x4*)(FG + off + bj * HALF) = pack8(v0, v1); } }
    }
};

template <class Epi, class Sched, bool ALIGN_EPI = false, bool SP2 = false, bool HALF_M = false>
__device__ __forceinline__ void gemm_phase(PG8_LAS unsigned char* lds, const Gemm g, const Sched& S, const Epi& E, const int wid_s) {
    int lane_l = lane_id(); asm volatile("" : "+v"(lane_l));
    const int wid = wid_s, lane = lane_l, tid = wid * 64 + lane, wr = wid >> 2, wc = wid & 3, fr = lane & 15, fq = lane >> 4;
    int K_l = g.K; asm volatile("" : "+s"(K_l)); const int K = K_l, nt = K / BK;
    unsigned voffA[2], voffB[2];
#pragma unroll
    for (int i = 0; i < 2; ++i) { int R, C; stage_rc(tid * 16 + i * 8192, R, C); const int Rb = Epi::PERM ? ((R & ~31) + perm32(R & 31)) : R;
        voffA[i] = (unsigned)(R * g.lda + C) * 2u; voffB[i] = (unsigned)(Rb * g.ldb + C) * 2u; }
    const size_t kstep = (size_t)(BK * 2);
    const size_t hstepA = (size_t)HALF * g.lda * 2, hstepB = (size_t)HALF * g.ldb * 2;
    const size_t tstepA = 2 * hstepA;
    const unsigned ldsw = (unsigned)wid * 1024u;
    const int aoff = lds_byte(wr * 64 + fr, fq * 8), boff = lds_byte(wc * 32 + fr, fq * 8);
#define PG8_SA(b, h) (((b) * 2 + (h)) * HTB)
#define PG8_SB(b, h) ((4 + (b) * 2 + (h)) * HTB)
#define PG8_STAGE(bufoff, gbase, voff) do { _Pragma("unroll") for (int _i = 0; _i < 2; ++_i) \
        __builtin_amdgcn_global_load_lds((const unsigned*)((const char*)(gbase) + (voff)[_i]), (PG8_LAS unsigned*)(lds + (bufoff) + ldsw + _i * 8192), 16, 0, 0); } while (0)
#define PG8_LDA(dst, b, h) do { _Pragma("unroll") for (int m = 0; m < 4; ++m) _Pragma("unroll") for (int k = 0; k < 2; ++k) dst[m][k] = *(const PG8_LAS bf16x8*)(lds + PG8_SA(b, h) + aoff + m * 2048 + k * 1024); } while (0)
#define PG8_LDB(dst, b, h) do { _Pragma("unroll") for (int n = 0; n < 2; ++n) _Pragma("unroll") for (int k = 0; k < 2; ++k) dst[n][k] = *(const PG8_LAS bf16x8*)(lds + PG8_SB(b, h) + boff + n * 2048 + k * 1024); } while (0)
#define PG8_MMA(ai, bj, At, Bt) do { __builtin_amdgcn_s_setprio(1); _Pragma("unroll") for (int m = 0; m < 4; ++m) _Pragma("unroll") for (int n = 0; n < 2; ++n) _Pragma("unroll") for (int k = 0; k < 2; ++k) \
        acc[ai][bj][m][n] = __builtin_amdgcn_mfma_f32_16x16x32_bf16(Bt[n][k], At[m][k], acc[ai][bj][m][n], 0, 0, 0); __builtin_amdgcn_s_setprio(0); } while (0)
#define PG8_WAIT_V(n) asm volatile("s_waitcnt vmcnt(" #n ")" ::: "memory")
#define PG8_WAIT_L(n) asm volatile("s_waitcnt lgkmcnt(" #n ")" ::: "memory")
#define PG8_BAR __builtin_amdgcn_s_barrier()
#define PG8_SCHED __builtin_amdgcn_sched_barrier(0)
    Unit cur, nxt; int ui = 0;
    if (!S.next(0, cur)) return;
    f32x4 acc[2][2][4][2];
#pragma unroll
    for (int a = 0; a < 2; ++a)
#pragma unroll
        for (int b = 0; b < 2; ++b)
#pragma unroll
            for (int m = 0; m < 4; ++m)
#pragma unroll
                for (int n = 0; n < 2; ++n) acc[a][b][m][n] = (f32x4){0.f, 0.f, 0.f, 0.f};
    bf16x8 At[4][2], B0[2][2], B1[2][2];
    const char* cA = (const char*)g.A + (size_t)cur.pm * tstepA + (size_t)cur.pn * g.a_pn_off; const char* cB = (const char*)g.Bt + (size_t)cur.pn * g.b_pn_step;
    S.a_ready(cur);
    if constexpr (SP2) {
        PG8_STAGE(PG8_SB(0, 0), cB, voffB); PG8_STAGE(PG8_SB(0, 1), cB + hstepB, voffB); PG8_STAGE(PG8_SA(0, 0), cA, voffA); PG8_STAGE(PG8_SA(0, 1), cA + hstepA, voffA);
        if (wr == 1) PG8_BAR;
        PG8_WAIT_V(2); PG8_BAR;
        PG8_STAGE(PG8_SB(1, 0), cB + kstep, voffB); PG8_STAGE(PG8_SA(1, 0), cA + kstep, voffA); PG8_STAGE(PG8_SB(1, 1), cB + hstepB + kstep, voffB);
        PG8_WAIT_V(6); PG8_BAR;
    } else {
        PG8_STAGE(PG8_SB(0, 0), cB, voffB); PG8_STAGE(PG8_SA(0, 0), cA, voffA); PG8_STAGE(PG8_SB(0, 1), cB + hstepB, voffB); PG8_STAGE(PG8_SA(0, 1), cA + hstepA, voffA);
        if (wr == 1) PG8_BAR;
        PG8_WAIT_V(4); PG8_BAR;
        PG8_STAGE(PG8_SB(1, 0), cB + kstep, voffB); PG8_STAGE(PG8_SA(1, 0), cA + kstep, voffA); PG8_STAGE(PG8_SB(1, 1), cB + hstepB + kstep, voffB);
        PG8_WAIT_V(6); PG8_BAR;
    }
    for (;;) {
        const bool has_next = S.next(ui + 1, nxt);
        const char* nA = has_next ? (const char*)g.A + (size_t)nxt.pm * tstepA + (size_t)nxt.pn * g.a_pn_off : cA; const char* nB = has_next ? (const char*)g.Bt + (size_t)nxt.pn * g.b_pn_step : cB;
        for (int t = 0; t < nt; t += 2) {
            const bool last = (t == nt - 2);
            const char* a1 = cA + (size_t)(t + 1) * kstep;
            const char* a2 = last ? nA : cA + (size_t)(t + 2) * kstep; const char* b2 = last ? nB : cB + (size_t)(t + 2) * kstep;
            const char* a3 = a2 + kstep; const char* b3 = b2 + kstep;
            if (last && has_next) S.a_ready(nxt);
            if constexpr (SP2) {
            PG8_LDB(B0, 0, 0); PG8_LDB(B1, 0, 1); PG8_SCHED; PG8_LDA(At, 0, 0); PG8_STAGE(PG8_SA(1, 1), a1 + hstepA, voffA);
            PG8_WAIT_V(8); PG8_WAIT_L(0); PG8_BAR; PG8_MMA(0, 0, At, B0); PG8_MMA(0, 1, At, B1); PG8_BAR; PG8_SCHED;
            if constexpr (!HALF_M) { PG8_LDA(At, 0, 1); } PG8_STAGE(PG8_SB(0, 0), b2, voffB); PG8_STAGE(PG8_SB(0, 1), b2 + hstepB, voffB); PG8_STAGE(PG8_SA(0, 0), a2, voffA);
            PG8_WAIT_V(8); PG8_WAIT_L(0); PG8_BAR; if constexpr (!HALF_M) { PG8_MMA(1, 0, At, B0); PG8_MMA(1, 1, At, B1); } PG8_BAR; PG8_SCHED;
            PG8_LDB(B0, 1, 0); PG8_LDB(B1, 1, 1); PG8_SCHED; PG8_LDA(At, 1, 0); PG8_STAGE(PG8_SA(0, 1), a2 + hstepA, voffA);
            PG8_WAIT_V(8); PG8_WAIT_L(0); PG8_BAR; PG8_MMA(0, 0, At, B0); PG8_MMA(0, 1, At, B1); PG8_BAR; PG8_SCHED;
            if constexpr (!HALF_M) { PG8_LDA(At, 1, 1); } PG8_STAGE(PG8_SB(1, 0), b3, voffB); PG8_STAGE(PG8_SB(1, 1), b3 + hstepB, voffB); PG8_STAGE(PG8_SA(1, 0), a3, voffA);
            PG8_WAIT_V(8); PG8_WAIT_L(0); PG8_BAR; if constexpr (!HALF_M) { PG8_MMA(1, 0, At, B0); PG8_MMA(1, 1, At, B1); } PG8_BAR; PG8_SCHED;
            } else {
            PG8_LDB(B0, 0, 0); PG8_SCHED; PG8_LDA(At, 0, 0); PG8_STAGE(PG8_SA(1, 1), a1 + hstepA, voffA);
            PG8_WAIT_L(8); PG8_BAR; PG8_WAIT_L(0); PG8_MMA(0, 0, At, B0); PG8_BAR; PG8_SCHED;
            PG8_LDB(B1, 0, 1); PG8_STAGE(PG8_SB(0, 0), b2, voffB);
            PG8_BAR; PG8_WAIT_L(0); PG8_MMA(0, 1, At, B1); PG8_BAR;
            PG8_LDA(At, 0, 1); PG8_STAGE(PG8_SA(0, 0), a2, voffA);
            PG8_BAR; PG8_WAIT_L(0); PG8_MMA(1, 0, At, B0); PG8_BAR; PG8_SCHED;
            PG8_STAGE(PG8_SB(0, 1), b2 + hstepB, voffB);
            PG8_WAIT_V(6); PG8_BAR; PG8_MMA(1, 1, At, B1); PG8_BAR;
            PG8_LDB(B0, 1, 0); PG8_SCHED; PG8_LDA(At, 1, 0); PG8_STAGE(PG8_SA(0, 1), a2 + hstepA, voffA);
            PG8_WAIT_L(8); PG8_BAR; PG8_WAIT_L(0); PG8_MMA(0, 0, At, B0); PG8_BAR; PG8_SCHED;
            PG8_LDB(B1, 1, 1); PG8_STAGE(PG8_SB(1, 0), b3, voffB);
            PG8_BAR; PG8_WAIT_L(0); PG8_MMA(0, 1, At, B1); PG8_BAR;
            PG8_LDA(At, 1, 1); PG8_STAGE(PG8_SA(1, 0), a3, voffA);
            PG8_BAR; PG8_WAIT_L(0); PG8_MMA(1, 0, At, B0); PG8_BAR; PG8_SCHED;
            PG8_STAGE(PG8_SB(1, 1), b3 + hstepB, voffB);
            PG8_WAIT_V(6); PG8_BAR; PG8_MMA(1, 1, At, B1); PG8_BAR;
            }
        }
        if constexpr (ALIGN_EPI) { if (wr == 0) PG8_BAR; }
        if constexpr (!Epi::AFTER_DRAIN) { E(acc, cur, wr, wc, fr, fq); S.done(cur); }
        if (!has_next) break;
#pragma unroll
        for (int a = 0; a < 2; ++a)
#pragma unroll
            for (int b = 0; b < 2; ++b)
#pragma unroll
                for (int m = 0; m < 4; ++m)
#pragma unroll
                    for (int n = 0; n < 2; ++n) acc[a][b][m][n] = (f32x4){0.f, 0.f, 0.f, 0.f};
        cur = nxt; cA = nA; cB = nB; ++ui;
        if constexpr (ALIGN_EPI) { if (wr == 1) PG8_BAR; }
    }
    PG8_WAIT_V(0);
    if constexpr (!ALIGN_EPI) { if (wr == 0) PG8_BAR; }
    PG8_BAR;
    if constexpr (Epi::AFTER_DRAIN) { E.fused(acc, cur, wr, wc, fr, fq, lds, wid, lane); S.done(cur); }
#undef PG8_SA
#undef PG8_SB
#undef PG8_STAGE
#undef PG8_LDA
#undef PG8_LDB
#undef PG8_MMA
#undef PG8_WAIT_V
#undef PG8_WAIT_L
#undef PG8_BAR
#undef PG8_SCHED
}
}

namespace att {
typedef unsigned short bf16;
constexpr int   D = 128, NW = 8, QBLK = 32, KVBLK = 64;
constexpr float SCALE = 0.088388347648318440f;
constexpr float THR = 8.f;
constexpr int SDEPTH = 1;
constexpr int LDQ = 5120, LDK = 128, LDO = 2048;
constexpr size_t SHM_V = KVBLK * D * 2, SHM_K = KVBLK * D * 2, SHM_ATTN = 2 * SHM_V + 2 * SHM_K + NW * 64 * 4;
using bf16x8 = __attribute__((ext_vector_type(8))) short;
using s16x4  = __attribute__((ext_vector_type(4))) short;
using f32x16 = __attribute__((ext_vector_type(16))) float;
using f32x8  = __attribute__((ext_vector_type(8))) float;
using u32x4  = __attribute__((ext_vector_type(4))) unsigned;
#define KSWZ(row, colB) ((row) * 256 + ((colB) ^ (((row) & 15) << 4)))
#define SBAR() __builtin_amdgcn_sched_barrier(0)
__device__ __forceinline__ int crow(int r, int hi) { return (r & 3) + 8 * (r >> 2) + 4 * hi; }
__device__ __forceinline__ unsigned cvtpk(float lo, float hi) {
  unsigned r; asm volatile("v_cvt_pk_bf16_f32 %0, %1, %2" : "=v"(r) : "v"(lo), "v"(hi)); return r;
}
template <typename TIn> struct Stage;
template <> struct Stage<bf16>  { using T = bf16x8;
  __device__ static __forceinline__ T ld8(const bf16* p) { return *reinterpret_cast<const bf16x8*>(p); }
  __device__ static __forceinline__ bf16x8 tobf(T x) { return x; } };
template <> struct Stage<float> { using T = f32x8;
  __device__ static __forceinline__ T ld8(const float* p) { return *reinterpret_cast<const f32x8*>(p); }
  __device__ static __forceinline__ bf16x8 tobf(T x) {
    u32x4 w = {cvtpk(x[0], x[1]), cvtpk(x[2], x[3]), cvtpk(x[4], x[5]), cvtpk(x[6], x[7])}; return *reinterpret_cast<bf16x8*>(&w); } };

template <bool FAST>
__device__ __forceinline__ void partialSM(f32x16& p0, f32x16& p1, float& m_reg, float& mn, float& alpha) {
  if constexpr (FAST) {
    alpha = 1.f; mn = m_reg;
    for (int r = 0; r < 16; ++r) p0[r] = __builtin_amdgcn_exp2f(p0[r]);
    return;
  }
  constexpr float C = SCALE * 1.4426950408889634f;
  float pmax = p0[0]; for (int r = 1; r < 16; ++r) pmax = fmaxf(pmax, p0[r]); for (int r = 0; r < 16; ++r) pmax = fmaxf(pmax, p1[r]);
  { auto rr = __builtin_amdgcn_permlane32_swap(__float_as_uint(pmax), __float_as_uint(pmax), false, false);
    pmax = fmaxf(__uint_as_float(rr[0]), __uint_as_float(rr[1])); }
  if (__builtin_expect(__all(pmax - m_reg <= THR / SCALE), 1)) { mn = m_reg; alpha = 1.f; }
  else { mn = fmaxf(m_reg, pmax); alpha = __builtin_amdgcn_exp2f((m_reg - mn) * C); m_reg = mn; }
  float mnC = -mn * C;
  for (int r = 0; r < 16; ++r) p0[r] = fmaf(p0[r], C, mnC); for (int r = 0; r < 16; ++r) p1[r] = fmaf(p1[r], C, mnC);
  for (int r = 0; r < 16; ++r) p0[r] = __builtin_amdgcn_exp2f(p0[r]);
}
__device__ __forceinline__ void finishSM(f32x16& p0, f32x16& p1, float alpha, float& l_reg, bf16x8& pa0, bf16x8& pa1, bf16x8& pa2, bf16x8& pa3) {
  for (int r = 0; r < 16; ++r) p1[r] = __builtin_amdgcn_exp2f(p1[r]);
  float ps = 0; for (int r = 0; r < 16; ++r) ps += p0[r]; for (int r = 0; r < 16; ++r) ps += p1[r];
  { auto rr = __builtin_amdgcn_permlane32_swap(__float_as_uint(ps), __float_as_uint(ps), false, false);
    ps = __uint_as_float(rr[0]) + __uint_as_float(rr[1]); }
  l_reg = l_reg * alpha + ps;
#define PK4(P, BASE, OUT) do { unsigned a0 = cvtpk(P[BASE + 0], P[BASE + 1]), a1 = cvtpk(P[BASE + 2], P[BASE + 3]);   \
    unsigned b0 = cvtpk(P[BASE + 4], P[BASE + 5]), b1 = cvtpk(P[BASE + 6], P[BASE + 7]);                              \
    auto r0 = __builtin_amdgcn_permlane32_swap(a0, b0, false, false); auto r1 = __builtin_amdgcn_permlane32_swap(a1, b1, false, false); \
    u32x4 w = {r0[0], r1[0], r0[1], r1[1]}; OUT = *reinterpret_cast<bf16x8*>(&w); } while (0)
  PK4(p0, 0, pa0); PK4(p0, 8, pa1); PK4(p1, 0, pa2); PK4(p1, 8, pa3);
#undef PK4
}
__device__ __forceinline__ void qkt(f32x16& p0, f32x16& p1, const bf16* Ks, const bf16x8* qr, int r32, int hi, const float init) {
#define KLD(d0, row) (*reinterpret_cast<const bf16x8*>((const char*)Ks + KSWZ((row) + r32, ((d0) * 16 + hi * 8) * 2)))
  p0 = f32x16{}; p1 = f32x16{}; (void)init;
  bf16x8 a0 = KLD(0, 0), a1 = KLD(0, 32), b0 = KLD(1, 0), b1 = KLD(1, 32);
#pragma unroll
  for (int d0 = 0; d0 < 8; d0 += 2) {
    bf16x8 c0 = a0, c1 = a1, e0 = b0, e1 = b1;
    if (d0 + 2 < 8) { c0 = KLD(d0 + 2, 0); c1 = KLD(d0 + 2, 32); }
    p0 = __builtin_amdgcn_mfma_f32_32x32x16_bf16(a0, qr[d0], p0, 0, 0, 0);
    p1 = __builtin_amdgcn_mfma_f32_32x32x16_bf16(a1, qr[d0], p1, 0, 0, 0);
    if (d0 + 3 < 8) { e0 = KLD(d0 + 3, 0); e1 = KLD(d0 + 3, 32); }
    p0 = __builtin_amdgcn_mfma_f32_32x32x16_bf16(b0, qr[d0 + 1], p0, 0, 0, 0);
    p1 = __builtin_amdgcn_mfma_f32_32x32x16_bf16(b1, qr[d0 + 1], p1, 0, 0, 0);
    a0 = c0; a1 = c1; b0 = e0; b1 = e1;
  }
#undef KLD
}
__device__ __forceinline__ int v_st(int k, int c) { const int kk = (k & ~0xC) | ((k & 4) << 1) | ((k & 8) >> 1); return ((kk >> 3) * 4 + (c >> 5)) * 512 + ((kk & 7) * 32 + (c & 31)) * 2; }
__device__ __forceinline__ int v_rd_base(int lane) { return ((lane & 3) << 3) | (((lane >> 2) & 3) << 6) | (((lane >> 4) & 1) << 5) | (((lane >> 5) & 1) << 8); }
constexpr int v_rd_off(int d0, int ks, int half) { return d0 * 512 + ks * 4096 + half * 2048; }
template <int OFF> __device__ __forceinline__ s16x4 tr_read(int vb) {
  s16x4 r; asm volatile("ds_read_b64_tr_b16 %0, %1 offset:%2" : "=&v"(r) : "v"(vb), "i"(OFF) : "memory"); return r;
}
template <int D0> __device__ __forceinline__ void pv_one(f32x16& od, int vb, bf16x8 pa0, bf16x8 pa1, bf16x8 pa2, bf16x8 pa3) {
  const s16x4 l0 = tr_read<v_rd_off(D0, 0, 0)>(vb), h0 = tr_read<v_rd_off(D0, 0, 1)>(vb), l1 = tr_read<v_rd_off(D0, 1, 0)>(vb), h1 = tr_read<v_rd_off(D0, 1, 1)>(vb);
  const s16x4 l2 = tr_read<v_rd_off(D0, 2, 0)>(vb), h2 = tr_read<v_rd_off(D0, 2, 1)>(vb), l3 = tr_read<v_rd_off(D0, 3, 0)>(vb), h3 = tr_read<v_rd_off(D0, 3, 1)>(vb);
  asm volatile("s_waitcnt lgkmcnt(0)" ::: "memory"); SBAR();
#define PK(L, H) (bf16x8){L[0], L[1], L[2], L[3], H[0], H[1], H[2], H[3]}
  od = __builtin_amdgcn_mfma_f32_32x32x16_bf16(pa0, PK(l0, h0), od, 0, 0, 0);
  od = __builtin_amdgcn_mfma_f32_32x32x16_bf16(pa1, PK(l1, h1), od, 0, 0, 0);
  od = __builtin_amdgcn_mfma_f32_32x32x16_bf16(pa2, PK(l2, h2), od, 0, 0, 0);
  od = __builtin_amdgcn_mfma_f32_32x32x16_bf16(pa3, PK(l3, h3), od, 0, 0, 0);
#undef PK
}
__device__ __forceinline__ void pv_d0(f32x16* o, int vb, bf16x8 pa0, bf16x8 pa1, bf16x8 pa2, bf16x8 pa3) {
  pv_one<0>(o[0], vb, pa0, pa1, pa2, pa3); pv_one<1>(o[1], vb, pa0, pa1, pa2, pa3); pv_one<2>(o[2], vb, pa0, pa1, pa2, pa3); pv_one<3>(o[3], vb, pa0, pa1, pa2, pa3);
}

template <bool FAST>
__device__ __forceinline__ void attn_dense_body(const bf16* __restrict__ Qb, const bf16* __restrict__ Kh, const bf16* __restrict__ Vh,
                                                const bf16* __restrict__ Gb, bf16* __restrict__ Ob, const float* __restrict__ qg, const int t0, const float negBC, int seq, char* lds, const int wid, const int lane) {
  using TQ = bf16; using St = Stage<bf16>; using SQ = Stage<bf16>;
  const int tid = wid * 64 + lane, r32 = lane & 31, hi = lane >> 5;
  bf16* V_lds = (bf16*)lds; bf16* K_lds = (bf16*)(lds + 2 * SHM_V);
  float* ws = (float*)(lds + 2 * SHM_V + 2 * SHM_K) + wid * 64; float* li_l = ws; float* al_l = ws + 32;
  float m_reg = -1e30f, l_reg = 0; f32x16 o[4] = {}; bf16x8 qr[8];
  const bf16* Qw = Qb + (long)(wid * QBLK + r32) * LDQ + hi * 8;
  {
    bf16x8 raw[8]; float ss = 0.f;
#pragma unroll
    for (int d0 = 0; d0 < 8; ++d0) { raw[d0] = *reinterpret_cast<const bf16x8*>(Qw + d0 * 16);
#pragma unroll
      for (int j = 0; j < 8; ++j) { const float f = __uint_as_float((unsigned)(unsigned short)raw[d0][j] << 16); ss += f * f; } }
    { float a = ss, b = ss; asm volatile("s_nop 1\n\tv_permlane32_swap_b32 %0, %1\n\ts_nop 1" : "+v"(a), "+v"(b)); ss = a + b; }
    const float rstd = rsqrtf(ss * (1.f / 128.f) + 1e-6f);
    const int tq = t0 + wid * QBLK + r32; const float prow = (float)(tq >> 6), pcol = (float)(tq & 63);
#pragma unroll
    for (int d0 = 0; d0 < 8; ++d0) { const float pos = d0 < 4 ? prow : pcol;
      const float* gp = qg + d0 * 16 + hi * 8; const float g8[8] = {gp[0], gp[1], gp[2], gp[3], gp[4], gp[5], gp[6], gp[7]};
      float y[8];
#pragma unroll
      for (int j = 0; j < 8; ++j) y[j] = __uint_as_float((unsigned)(unsigned short)raw[d0][j] << 16) * rstd * g8[j] * (FAST ? SCALE * 1.4426950408889634f : 1.f);
      u32x4 w;
#pragma unroll
      for (int jj = 0; jj < 4; ++jj) { const int fi = (d0 & 3) * 8 + hi * 4 + jj;
        float xr = pos * exp2f(-(float)fi * (13.287712379549449f / 32.f)) * 0.15915494309189535f; xr -= floorf(xr);
        const float c = __builtin_amdgcn_cosf(xr), sn = __builtin_amdgcn_sinf(xr);
        w[jj] = cvtpk(y[2 * jj] * c - y[2 * jj + 1] * sn, y[2 * jj] * sn + y[2 * jj + 1] * c); }
      qr[d0] = *reinterpret_cast<bf16x8*>(&w); }
  }
  const int sr = tid >> 4, sc = (tid & 15) * 8, vst0 = v_st(sr, sc), vst1 = v_st(32 + sr, sc);
  const int vb0 = (int)(uintptr_t)V_lds + v_rd_base(lane);
  struct { typename St::T vs0, vs1, ks0, ks1; } sr_[SDEPTH];
#define SLOAD(i, k0) do { sr_[i].vs0 = St::ld8(&Vh[(long)((k0) + sr) * LDK + sc]); sr_[i].vs1 = St::ld8(&Vh[(long)((k0) + 32 + sr) * LDK + sc]); \
    sr_[i].ks0 = St::ld8(&Kh[(long)((k0) + sr) * LDK + sc]); sr_[i].ks1 = St::ld8(&Kh[(long)((k0) + 32 + sr) * LDK + sc]); } while (0)
#define SWRITE(b, i) do { *(bf16x8*)((char*)V_lds + (b) * SHM_V + vst0) = St::tobf(sr_[i].vs0);          \
    *(bf16x8*)((char*)V_lds + (b) * SHM_V + vst1) = St::tobf(sr_[i].vs1); int kc = sc * 2;               \
    *(bf16x8*)((char*)K_lds + (b) * SHM_K + KSWZ(sr, kc)) = St::tobf(sr_[i].ks0);                       \
    *(bf16x8*)((char*)K_lds + (b) * SHM_K + KSWZ(32 + sr, kc)) = St::tobf(sr_[i].ks1); } while (0)
#define SWAIT() do { if constexpr (SDEPTH == 2) asm volatile("s_waitcnt vmcnt(4)" ::: "memory"); else asm volatile("s_waitcnt vmcnt(0)" ::: "memory"); } while (0)
#define RESC(a) do { if (__any((a) < 1.f)) { if (hi == 0) al_l[r32] = (a); asm volatile("s_waitcnt lgkmcnt(0)" ::: "memory"); \
    for (int d = 0; d < 4; ++d) for (int r = 0; r < 16; ++r) o[d][r] *= al_l[crow(r, hi)]; } } while (0)
  f32x16 pA0, pA1, pB0, pB1; float mnA, mnB, alA, alB; bf16x8 pa0, pa1, pa2, pa3; const int NT = seq / KVBLK;
  constexpr int SE = 0, SO = SDEPTH - 1;
  SLOAD(SE, 0); asm volatile("s_waitcnt vmcnt(0)" ::: "memory"); SWRITE(0, SE); __syncthreads();
  const float sinit = FAST ? negBC : 0.f;
  qkt(pA0, pA1, K_lds, qr, r32, hi, sinit); partialSM<FAST>(pA0, pA1, m_reg, mnA, alA);
  SLOAD(SO, KVBLK); if constexpr (SDEPTH == 2) { if (2 < NT) SLOAD(SE, 2 * KVBLK); }
  SWAIT(); SWRITE(1, SO); __syncthreads();
#define STEP_LEAD(PN0, PN1, KB, PO0, PO1, ALO, LOADS, VB, MNN, ALN, WB, WSL) do { \
    SBAR(); qkt(PN0, PN1, KB, qr, r32, hi, sinit); finishSM(PO0, PO1, ALO, l_reg, pa0, pa1, pa2, pa3); SBAR(); LOADS; SBAR(); \
    pv_d0(o, VB, pa0, pa1, pa2, pa3); partialSM<FAST>(PN0, PN1, m_reg, MNN, ALN); \
    __syncthreads(); SWAIT(); SWRITE(WB, WSL); if constexpr (!FAST) RESC(ALN); __syncthreads(); } while (0)
#define STEP_TRAIL(PN0, PN1, KB, PO0, PO1, ALO, LOADS, VB, MNN, ALN, WB, WSL) do { \
    SBAR(); finishSM(PO0, PO1, ALO, l_reg, pa0, pa1, pa2, pa3); SBAR(); LOADS; SBAR(); qkt(PN0, PN1, KB, qr, r32, hi, sinit); SBAR(); \
    partialSM<FAST>(PN0, PN1, m_reg, MNN, ALN); SBAR(); pv_d0(o, VB, pa0, pa1, pa2, pa3); \
    __syncthreads(); SWAIT(); SWRITE(WB, WSL); if constexpr (!FAST) RESC(ALN); __syncthreads(); } while (0)
  bf16* const K1 = (bf16*)((char*)K_lds + SHM_K);
  if (wid < 8) {
    for (int j = 1; j + 1 < NT; j += 2) {
      STEP_LEAD(pB0, pB1, K1, pA0, pA1, alA, SLOAD(SO, (j + SDEPTH) * KVBLK), vb0, mnB, alB, 0, SE);
      STEP_LEAD(pA0, pA1, K_lds, pB0, pB1, alB, if (SDEPTH == 1 || j + 3 < NT) SLOAD(SE, (j + 1 + SDEPTH) * KVBLK), vb0 + (int)SHM_V, mnA, alA, 1, SO);
    }
  } else {
    for (int j = 1; j + 1 < NT; j += 2) {
      STEP_TRAIL(pB0, pB1, K1, pA0, pA1, alA, SLOAD(SO, (j + SDEPTH) * KVBLK), vb0, mnB, alB, 0, SE);
      STEP_TRAIL(pA0, pA1, K_lds, pB0, pB1, alB, if (SDEPTH == 1 || j + 3 < NT) SLOAD(SE, (j + 1 + SDEPTH) * KVBLK), vb0 + (int)SHM_V, mnA, alA, 1, SO);
    }
  }
#undef STEP_LEAD
#undef STEP_TRAIL
  SBAR(); qkt(pB0, pB1, (bf16*)((char*)K_lds + SHM_K), qr, r32, hi, sinit);
  finishSM(pA0, pA1, alA, l_reg, pa0, pa1, pa2, pa3); SBAR();
  pv_d0(o, vb0, pa0, pa1, pa2, pa3); partialSM<FAST>(pB0, pB1, m_reg, mnB, alB);
  __syncthreads(); if constexpr (!FAST) RESC(alB);
  finishSM(pB0, pB1, alB, l_reg, pa0, pa1, pa2, pa3); SBAR();
  pv_d0(o, vb0 + (int)SHM_V, pa0, pa1, pa2, pa3);
  if (hi == 0) li_l[r32] = l_reg; asm volatile("s_waitcnt lgkmcnt(0)" ::: "memory");
  float rli[16];
#pragma unroll
  for (int r = 0; r < 16; ++r) rli[r] = __builtin_amdgcn_rcpf(li_l[crow(r, hi)]);
  int lane_e = lane_id(); asm volatile("" : "+v"(lane_e)); const int r32e = lane_e & 31, hie = lane_e >> 5;
  bf16* Ow = Ob + (long)(wid * QBLK) * LDO; const bf16* Gw = Gb + (long)(wid * QBLK) * LDQ;
#pragma unroll
  for (int r = 0; r < 16; ++r) { int orow = crow(r, hie);
#pragma unroll
    for (int d0 = 0; d0 < 4; ++d0) { const float gt = __uint_as_float((unsigned)Gw[(long)orow * LDQ + d0 * 32 + r32e] << 16);
      const float sg = gt * __builtin_amdgcn_rcpf(1.f + __expf(-gt));
      Ow[(long)orow * LDO + d0 * 32 + r32e] = f2bf_rne(o[d0][r] * rli[r] * sg); } }
#undef SLOAD
#undef SWRITE
#undef SWAIT
#undef RESC
}
}

constexpr int DM = 2048, BATCH = 4, SEQ = 8192, MTOK = BATCH * SEQ;
constexpr int N_IN1 = 5120, N_IN2 = 4096;
constexpr int NTHR = 512, NWAVE = 8;
constexpr size_t MiB = 1u << 20;
constexpr size_t WS_BAR = 60 * MiB;
constexpr size_t WS_WT1 = 0, WS_WT2 = 20 * MiB, WS_WT3 = 28 * MiB, WS_WT4 = 44 * MiB, WS_DFTC = 52 * MiB, WS_MODP = 53 * MiB, WS_MOD = 59 * MiB;
constexpr size_t WS_W1 = 52 * MiB + 256 * 1024, WS_W2 = 52 * MiB + 512 * 1024;
constexpr size_t WS_TP = 64 * MiB;
constexpr size_t WS_H = 320 * MiB;
constexpr size_t WS_QKVG = 448 * MiB;
constexpr size_t WS_OG = 768 * MiB;
constexpr size_t WS_U = 448 * MiB, WS_SG = 576 * MiB, WS_UT = 768 * MiB, WS_Z = 320 * MiB, WS_FG = 768 * MiB;
constexpr size_t WS_KC = 896 * MiB, WS_VC = 928 * MiB;
constexpr size_t WS_X1 = 896 * MiB;
constexpr size_t WS_END = 1024 * MiB;
constexpr int LDS_BYTES = 131072 + 512 + 8192;
typedef unsigned short bf16;
typedef float f32x4 __attribute__((ext_vector_type(4)));
typedef unsigned u32x4 __attribute__((ext_vector_type(4)));
typedef unsigned u32x2 __attribute__((ext_vector_type(2)));
#define LDS_WAIT() asm volatile("s_waitcnt lgkmcnt(0)" ::: "memory")

template <int O> __device__ __forceinline__ float swz_xor(float v) { return __builtin_bit_cast(float, __builtin_amdgcn_ds_swizzle(__builtin_bit_cast(int, v), (O << 10) | 0x1f)); }
__device__ __forceinline__ float wave_sum(float v) {
    v += swz_xor<1>(v); v += swz_xor<2>(v); v += swz_xor<4>(v); v += swz_xor<8>(v); v += swz_xor<16>(v);
    float a = v, b = v;
    asm volatile("s_nop 1\n\tv_permlane32_swap_b32 %0, %1\n\ts_nop 1" : "+v"(a), "+v"(b));
    return a + b;
}
__device__ __forceinline__ unsigned pk2(float lo, float hi) { return (unsigned)f2bf_rne(lo) | ((unsigned)f2bf_rne(hi) << 16); }

__device__ __forceinline__ void transpose_item(const float* W, int K, int N, bf16* WT, float* scr, int item, int lane) {
    const int nblk = N / 32, kb = item / nblk, nb = item % nblk, k0 = 64 * kb, n0 = 32 * nb;
#pragma unroll 8
    for (int i = 0; i < 32; ++i) { const int kk = 2 * i + (lane >> 5); scr[kk * 33 + (lane & 31)] = W[(size_t)(k0 + kk) * N + n0 + (lane & 31)]; }
    LDS_WAIT(); asm volatile("" ::: "memory");
    const int c = lane & 7;
#pragma unroll
    for (int j = 0; j < 4; ++j) { const int n = (lane >> 3) + 8 * j; const float* s = scr + (8 * c) * 33 + n;
        u32x4 o; o.x = pk2(s[0 * 33], s[1 * 33]); o.y = pk2(s[2 * 33], s[3 * 33]); o.z = pk2(s[4 * 33], s[5 * 33]); o.w = pk2(s[6 * 33], s[7 * 33]);
        *(u32x4*)(WT + (size_t)(n0 + n) * K + k0 + 8 * c) = o; }
    LDS_WAIT(); asm volatile("" ::: "memory");
}

__device__ __forceinline__ void mod_partial_item(const float* cvec, const float* ada_w, float* modp, int item, int lane) {
    const int l = item / 768, rem = item % 768, kc = rem / 24, cc = rem % 24, k0 = kc * 64, col0 = cc * 256 + lane * 4;
    float sc0 = silu_f(cvec[0 * DM + k0 + lane]), sc1 = silu_f(cvec[1 * DM + k0 + lane]), sc2 = silu_f(cvec[2 * DM + k0 + lane]), sc3 = silu_f(cvec[3 * DM + k0 + lane]);
    f32x4 a0 = {0.f, 0.f, 0.f, 0.f}, a1 = a0, a2 = a0, a3 = a0;
    const float* wp = ada_w + ((size_t)l * DM + k0) * 6144 + col0;
#pragma unroll 8
    for (int kk = 0; kk < 64; ++kk) { const f32x4 w = *(const f32x4*)(wp + (size_t)kk * 6144);
        const float s0 = __builtin_bit_cast(float, __builtin_amdgcn_readlane(__builtin_bit_cast(int, sc0), kk));
        const float s1 = __builtin_bit_cast(float, __builtin_amdgcn_readlane(__builtin_bit_cast(int, sc1), kk));
        const float s2 = __builtin_bit_cast(float, __builtin_amdgcn_readlane(__builtin_bit_cast(int, sc2), kk));
        const float s3 = __builtin_bit_cast(float, __builtin_amdgcn_readlane(__builtin_bit_cast(int, sc3), kk));
        a0 += w * s0; a1 += w * s1; a2 += w * s2; a3 += w * s3; }
    float* o = modp + (size_t)((kc * 2 + l) * 4) * 6144 + col0;
    *(f32x4*)(o) = a0; *(f32x4*)(o + 6144) = a1; *(f32x4*)(o + 2 * 6144) = a2; *(f32x4*)(o + 3 * 6144) = a3;
}

__device__ __forceinline__ f32x4 ld4f(const float* p) { return *(const f32x4*)p; }
__device__ __forceinline__ f32x4 ld4f(const bf16* p) { const u32x2 w = *(const u32x2*)p; return (f32x4){__builtin_bit_cast(float, w.x << 16), __builtin_bit_cast(float, w.x & 0xffff0000u), __builtin_bit_cast(float, w.y << 16), __builtin_bit_cast(float, w.y & 0xffff0000u)}; }
template <typename TX, bool PERMUTE>
__device__ __forceinline__ void norm_mod_rows(const TX* x, const float* g, const float* modl  , bf16* H, int gw, int ngw, int lane) {
    for (int row0 = gw * 16; row0 < MTOK; row0 += ngw * 16) {
        const int b = row0 / SEQ; const float* mb = modl + (size_t)b * 6144;
        f32x4 ca[8], cs[8];
#pragma unroll
        for (int j = 0; j < 8; ++j) { const int c = lane * 4 + 256 * j; const f32x4 gg = *(const f32x4*)(g + c), scv = *(const f32x4*)(mb + 2048 + c);
            ca[j] = gg * (scv + 1.0f); cs[j] = *(const f32x4*)(mb + c); }
        for (int rr = 0; rr < 16; ++rr) { const int row = row0 + rr, tt = row & (SEQ - 1); const size_t ro = (size_t)row * DM;
            const size_t wo = PERMUTE ? (size_t)((row - tt) + (tt & 63) * 128 + (tt >> 6)) * DM : ro;
            f32x4 v[8]; float ss = 0.f;
#pragma unroll
            for (int j = 0; j < 8; ++j) { v[j] = ld4f(x + ro + lane * 4 + 256 * j); ss += (v[j].x * v[j].x + v[j].y * v[j].y) + (v[j].z * v[j].z + v[j].w * v[j].w); }
            const float rstd = rsqrtf(wave_sum(ss) * (1.f / DM) + 1e-6f);
#pragma unroll
            for (int j = 0; j < 8; ++j) { const f32x4 y = v[j] * rstd * ca[j] + cs[j]; u32x2 w; w.x = pk2(y.x, y.y); w.y = pk2(y.z, y.w);
                *(u32x2*)(H + wo + lane * 4 + 256 * j) = w; } }
    }
}

__device__ __forceinline__ void k_norm_rope_rows(const bf16* P, bf16* KC, bf16* VC, const float* kg, int gw, int ngw, int lane) {
    const int l16 = lane & 15, kvh = lane >> 4;
    float gk[8], invf[4];
#pragma unroll
    for (int i = 0; i < 8; ++i) gk[i] = kg[l16 * 8 + i];
#pragma unroll
    for (int i = 0; i < 4; ++i) { const int j = (l16 * 4 + i) & 31; invf[i] = exp2f(-(float)j * (13.287712379549449f / 32.f)); }
    for (int row0 = gw * 16; row0 < MTOK; row0 += ngw * 16) {
#pragma unroll 4
        for (int rr = 0; rr < 16; ++rr) { const int row = row0 + rr, t = row & (SEQ - 1), bb = row >> 13;
            const float pos = (float)((l16 < 8) ? (t >> 6) : (t & 63));
            const bf16* rp = P + (size_t)row * 5120 + 2048 + lane * 8;
            const u32x4 w = *(const u32x4*)rp; const u32x4 vv = *(const u32x4*)(rp + 512);
            float cs[4], sn[4];
#pragma unroll
            for (int i = 0; i < 4; ++i) { float xr = pos * invf[i] * 0.15915494309189535f; xr -= floorf(xr); cs[i] = __builtin_amdgcn_cosf(xr); sn[i] = __builtin_amdgcn_sinf(xr); }
            float v[8] = {bf2f((bf16)(w.x & 0xffff)), bf2f((bf16)(w.x >> 16)), bf2f((bf16)(w.y & 0xffff)), bf2f((bf16)(w.y >> 16)),
                          bf2f((bf16)(w.z & 0xffff)), bf2f((bf16)(w.z >> 16)), bf2f((bf16)(w.w & 0xffff)), bf2f((bf16)(w.w >> 16))};
            float ss = 0.f;
#pragma unroll
            for (int i = 0; i < 8; ++i) ss += v[i] * v[i];
            ss += swz_xor<1>(ss); ss += swz_xor<2>(ss); ss += swz_xor<4>(ss); ss += swz_xor<8>(ss);
            const float rstd = rsqrtf(ss * (1.f / 128.f) + 1e-6f);
            float y[8];
#pragma unroll
            for (int i = 0; i < 8; ++i) y[i] = v[i] * rstd * gk[i];
            u32x4 o;
            o.x = pk2(y[0] * cs[0] - y[1] * sn[0], y[0] * sn[0] + y[1] * cs[0]);
            o.y = pk2(y[2] * cs[1] - y[3] * sn[1], y[2] * sn[1] + y[3] * cs[1]);
            o.z = pk2(y[4] * cs[2] - y[5] * sn[2], y[4] * sn[2] + y[5] * cs[2]);
            o.w = pk2(y[6] * cs[3] - y[7] * sn[3], y[6] * sn[3] + y[7] * cs[3]);
            const size_t co = (((size_t)(bb * 4 + kvh)) * SEQ + t) * 128 + l16 * 8;
            *(u32x4*)(KC + co) = o; *(u32x4*)(VC + co) = vv; }
    }
}

__device__ __forceinline__ void transpose_u_block(const bf16* U, bf16* UT, unsigned short* lt, int id, int tid) {
    const int ct = id & 31, n2g = (id >> 5) & 15, b = id >> 9;
#pragma unroll
    for (int i = 0; i < 8; ++i) { const int q = tid + 512 * i, row = q >> 3, ch = q & 7, n2l = row >> 7, n1 = row & 127, n = n1 * 64 + n2g * 4 + n2l;
        const u32x4 w = *(const u32x4*)(U + ((size_t)(b * SEQ + n)) * DM + ct * 64 + ch * 8);
        unsigned short* d = lt + (ch * 8) * 512 + ((((row >> 3) ^ ch) << 3) | (row & 7));
        d[0] = (unsigned short)(w.x & 0xffff); d[512] = (unsigned short)(w.x >> 16); d[1024] = (unsigned short)(w.y & 0xffff); d[1536] = (unsigned short)(w.y >> 16);
        d[2048] = (unsigned short)(w.z & 0xffff); d[2560] = (unsigned short)(w.z >> 16); d[3072] = (unsigned short)(w.w & 0xffff); d[3584] = (unsigned short)(w.w >> 16); }
    __syncthreads();
#pragma unroll
    for (int i = 0; i < 8; ++i) { const int o = tid + 512 * i, n1c = o & 15, n2l = (o >> 4) & 3, c = o >> 6, gi = n2l * 16 + n1c;
        const u32x4 w = *(const u32x4*)(lt + c * 512 + ((gi ^ ((c >> 3) & 7)) << 3));
        *(u32x4*)(UT + (((size_t)(b * DM + ct * 64 + c)) * 64 + n2g * 4 + n2l) * 128 + n1c * 8) = w; }
    __syncthreads();
}

#define XB_TMO      128
#define XB_XCNT(j)  (256  + 64 * (j))
#define XB_XSUB(j)  (1280 + 64 * (j))
#define XB_XGEN(j)  (2304 + 64 * (j))
#define XB_TOP      3328
#define XB_TOPGEN   3392
#define XCD_BAR_WORDS 3456
#define XB_SPIN_CAP (1u << 18)

__device__ __forceinline__ unsigned xb_ld(unsigned* p)              { return __hip_atomic_load(p, __ATOMIC_RELAXED, __HIP_MEMORY_SCOPE_AGENT); }
__device__ __forceinline__ unsigned xb_add(unsigned* p, unsigned v) { return __hip_atomic_fetch_add(p, v, __ATOMIC_RELAXED, __HIP_MEMORY_SCOPE_AGENT); }
__device__ __forceinline__ unsigned xb_xcc_id() { return (unsigned)__builtin_amdgcn_s_getreg((3 << 11) | 20) & 0xFu; }
#define XB_SPIN(cond, bar) do { unsigned _sp = 0; while (cond) { __builtin_amdgcn_s_sleep(1); \
    if ((++_sp & 255u) == 0u) { if (xb_ld(&(bar)[XB_TMO])) break; if (_sp > XB_SPIN_CAP) { atomicAdd(&(bar)[XB_TMO], 1u); break; } } } } while (0)

struct XcdBarrier {
    unsigned* bar; unsigned x;
    volatile __attribute__((address_space(3))) unsigned* st;
};

__device__ __forceinline__ XcdBarrier xcd_barrier_post(unsigned* bar, volatile __attribute__((address_space(3))) unsigned* st, const bool t0) {
    XcdBarrier b; b.bar = bar; b.x = xb_xcc_id(); b.st = st;
    if (t0) (void)xb_add(&bar[XB_XCNT(b.x)], 1u);
    return b;
}
__device__ __forceinline__ void xcd_barrier_complete(unsigned* bar, unsigned x, unsigned& nloc, unsigned& nx) {
    const unsigned G = gridDim.x * gridDim.y * gridDim.z;
    unsigned sum, cnt, mine, sp = 0u;
    for (;;) {
        sum = 0u; cnt = 0u; mine = 0u;
#pragma unroll
        for (unsigned j = 0; j < 16; ++j) { const unsigned c = xb_ld(&bar[XB_XCNT(j)]); sum += c; cnt += (c > 0u) ? 1u : 0u; mine = (j == x) ? c : mine; }
        if (sum == G) break;
        __builtin_amdgcn_s_sleep(1);
        if ((++sp & 255u) == 0u) { if (xb_ld(&bar[XB_TMO])) break; if (sp > XB_SPIN_CAP) { atomicAdd(&bar[XB_TMO], 1u); break; } }
    }
    nloc = mine > 0u ? mine : 1u; nx = cnt > 0u ? cnt : 1u;
}

__device__ __forceinline__ void xcd_barrier(const XcdBarrier& b, const bool t0) {
    asm volatile("s_waitcnt vmcnt(0)" ::: "memory");
    __syncthreads();
    if (t0) {
        unsigned* bar = b.bar;
        __builtin_amdgcn_s_waitcnt(0);
        unsigned nloc = b.st[0], nx = b.st[1];
        if (nloc == 0u) { xcd_barrier_complete(bar, b.x, nloc, nx); b.st[0] = nloc; b.st[1] = nx; }
        const unsigned old = xb_add(&bar[XB_XSUB(b.x)], 1u);
        const unsigned gen = old / nloc;
        if (old + 1u == (gen + 1u) * nloc) {
            __builtin_amdgcn_fence(__ATOMIC_RELEASE, "agent");
            asm volatile("s_waitcnt vmcnt(0)" ::: "memory");
            const unsigned og = xb_add(&bar[XB_TOP], 1u);
            const unsigned tg = og / nx;
            if (og + 1u == (tg + 1u) * nx) xb_add(&bar[XB_TOPGEN], 1u);
            else XB_SPIN(xb_ld(&bar[XB_TOPGEN]) == tg, bar);
            __builtin_amdgcn_fence(__ATOMIC_ACQUIRE, "agent");
            xb_add(&bar[XB_XGEN(b.x)], 1u);
            asm volatile("s_waitcnt vmcnt(0)" ::: "memory");
        } else {
            XB_SPIN(xb_ld(&bar[XB_XGEN(b.x)]) == gen, bar);
            __builtin_amdgcn_fence(__ATOMIC_ACQUIRE, "agent");
            asm volatile("s_waitcnt vmcnt(0)" ::: "memory");
        }
    }
    __syncthreads();
}

struct Args { const float* in[12]; float* out; unsigned char* ws; };

__global__ void __launch_bounds__(NTHR, 2) fwd_megakernel(Args args) {
    extern __shared__ __attribute__((aligned(16))) unsigned char lds[];
    cg::grid_group grid = cg::this_grid();
    const int G = gridDim.x, bx = blockIdx.x;
    const int wave_s = __builtin_amdgcn_readfirstlane((int)threadIdx.x >> 6);
    const int NGW = G * NWAVE; const long NGT = (long)G * NTHR;
#define PHASE_IDS() int lane_p = lane_id(); asm volatile("" : "+v"(lane_p)); const int lane = lane_p, wave = wave_s, tid = wave * 64 + lane; (void)tid; \
    const int gw = bx * NWAVE + wave; const long gt = (long)bx * NTHR + tid; (void)lane; (void)gw; (void)gt;
    typedef const float* cfptr_t; typedef float* fptr_t; typedef unsigned char* ucptr_t;
#define KA4 __attribute__((address_space(4)))
#define PTRS() const KA4 unsigned char* ka_ = (const KA4 unsigned char*)__builtin_amdgcn_kernarg_segment_ptr(); asm volatile("" : "+s"(ka_)); \
    const float* x = *(const KA4 cfptr_t*)(ka_ + 0); const float* cvec = *(const KA4 cfptr_t*)(ka_ + 8); const float* norm_g = *(const KA4 cfptr_t*)(ka_ + 16); \
    const float* ada_w = *(const KA4 cfptr_t*)(ka_ + 24); const float* ada_b = *(const KA4 cfptr_t*)(ka_ + 32); const float* attn_w_in = *(const KA4 cfptr_t*)(ka_ + 40); \
    const float* q_gain = *(const KA4 cfptr_t*)(ka_ + 48); const float* k_gain = *(const KA4 cfptr_t*)(ka_ + 56); const float* attn_w_out = *(const KA4 cfptr_t*)(ka_ + 64); \
    const float* f_w_in = *(const KA4 cfptr_t*)(ka_ + 72); const float* f_w_out = *(const KA4 cfptr_t*)(ka_ + 80); const float* final_g = *(const KA4 cfptr_t*)(ka_ + 88); \
    float* out = *(const KA4 fptr_t*)(ka_ + 96); unsigned char* ws = *(const KA4 ucptr_t*)(ka_ + 104); \
    bf16* WT1 = (bf16*)(ws + WS_WT1); bf16* WT2 = (bf16*)(ws + WS_WT2); bf16* WT3 = (bf16*)(ws + WS_WT3); bf16* WT4 = (bf16*)(ws + WS_WT4); \
    bf16* DFTC = (bf16*)(ws + WS_DFTC); bf16* FW1 = (bf16*)(ws + WS_W1); bf16* FW2 = (bf16*)(ws + WS_W2); bf16* TP = (bf16*)(ws + WS_TP); \
    float* MODP = (float*)(ws + WS_MODP); float* MOD = (float*)(ws + WS_MOD); bf16* KC = (bf16*)(ws + WS_KC); bf16* VC = (bf16*)(ws + WS_VC); bf16* X1 = (bf16*)(ws + WS_X1); (void)X1; \
    bf16* H = (bf16*)(ws + WS_H); bf16* QKVG = (bf16*)(ws + WS_QKVG); bf16* OG = (bf16*)(ws + WS_OG); \
    bf16* U = (bf16*)(ws + WS_U); bf16* SG = (bf16*)(ws + WS_SG); bf16* UT = (bf16*)(ws + WS_UT); bf16* Z = (bf16*)(ws + WS_Z); bf16* FG = (bf16*)(ws + WS_FG); \
    (void)x; (void)cvec; (void)norm_g; (void)ada_w; (void)ada_b; (void)attn_w_in; (void)q_gain; (void)k_gain; (void)attn_w_out; (void)f_w_in; (void)f_w_out; (void)final_g; (void)out; \
    (void)WT1; (void)WT2; (void)WT3; (void)WT4; (void)DFTC; (void)FW1; (void)FW2; (void)TP; (void)MODP; (void)MOD; (void)KC; (void)VC; (void)H; (void)QKVG; (void)OG; (void)U; (void)SG; (void)UT; (void)Z; (void)FG;
    __attribute__((address_space(3))) unsigned char* lds3 = (__attribute__((address_space(3))) unsigned char*)lds;
    volatile __attribute__((address_space(3))) unsigned* bar_st = (volatile __attribute__((address_space(3))) unsigned*)(lds3 + 131072 + 32);
    { PHASE_IDS(); if (tid < 64) ((volatile __attribute__((address_space(3))) unsigned*)(lds3 + 131072))[tid] = 0u; __syncthreads(); }

    {
        PHASE_IDS(); PTRS();
        if (bx == 0) { unsigned* bw = (unsigned*)(ws + WS_BAR); for (int i = tid; i < XCD_BAR_WORDS; i += NTHR) bw[i] = 0u; }
        float* scr = (float*)(lds + wave * 16384);
        constexpr int I1 = (DM / 64) * (N_IN1 / 32), I2 = (DM / 64) * (DM / 32), I3 = (DM / 64) * (N_IN2 / 32), I4 = I2, IM = 1536;
        for (int it = gw; it < IM + I1 + I2 + I3 + I4; it += NGW) {
            int r = it;
            if (r < IM) { mod_partial_item(cvec, ada_w, MODP, r, lane); continue; } r -= IM;
            if (r < I1) { transpose_item(attn_w_in, DM, N_IN1, WT1, scr, r, lane); continue; } r -= I1;
            if (r < I2) { transpose_item(attn_w_out, DM, DM, WT2, scr, r, lane); continue; } r -= I2;
            if (r < I3) { transpose_item(f_w_in, DM, N_IN2, WT3, scr, r, lane); continue; } r -= I3;
            transpose_item(f_w_out, DM, DM, WT4, scr, r, lane);
        }
        for (long i = gt; i < 256 * 128; i += NGT) { const int r = (int)(i >> 7), n1 = (int)(i & 127), ri = r >> 7, k1 = r & 127;
            const float xr = (float)((n1 * k1) & 127) * (1.f / 128.f);
            FW1[i] = f2bf_rne(ri ? -__builtin_amdgcn_sinf(xr) : __builtin_amdgcn_cosf(xr)); }
        for (long i = gt; i < 256 * 128; i += NGT) { const int r = (int)(i >> 7), j = (int)(i & 127), ro = (r >> 6) & 1, k2 = r & 63, ri = j >> 6, n2 = j & 63;
            const float xr = (float)((n2 * k2) & 63) * (1.f / 64.f); const float cv = __builtin_amdgcn_cosf(xr), sv = __builtin_amdgcn_sinf(xr);
            const float v = (ro == ri) ? cv : (ro == 0 ? sv : -sv);
            FW2[i] = f2bf_rne(r < 128 ? v : 0.f); }
        for (long i = gt; i < 256 * 512; i += NGT) { const int kc = (int)(i >> 9), j = (int)(i & 511), c = j & 255;
            const float xr = (float)((kc * c) & 255) * (1.f / 256.f);
            DFTC[i] = f2bf_rne(j < 256 ? __builtin_amdgcn_cosf(xr) : __builtin_amdgcn_sinf(xr)); }
    }
    grid.sync();
    XcdBarrier xbar;
    { PHASE_IDS(); PTRS(); xbar = xcd_barrier_post((unsigned*)(ws + WS_BAR), bar_st, tid == 0); }
#define GRID_BAR() do { int l_ = lane_id(); asm volatile("" : "+v"(l_)); xcd_barrier(xbar, (wave_s == 0) & (l_ == 0)); } while (0)
    { PHASE_IDS(); PTRS();
    for (long i = gt; i < 2 * 4 * 6144; i += NGT) { const int j = (int)(i % 6144), lb = (int)(i / 6144), l = lb >> 2;
        float s = ada_b[l * 6144 + j];
        for (int kc = 0; kc < 32; ++kc) s += MODP[(size_t)(kc * 8 + lb) * 6144 + j];
        MOD[i] = s; }
      if (gt == 0) { float mq = 0.f, mk = 0.f; for (int i = 0; i < 128; ++i) { mq = fmaxf(mq, fabsf(q_gain[i])); mk = fmaxf(mk, fabsf(k_gain[i])); } MOD[49152] = 128.f * mq * mk * 1.01f; } }
    GRID_BAR();
    { PHASE_IDS(); PTRS(); norm_mod_rows<float, false>(x, norm_g, MOD, H, gw, NGW, lane); }
    GRID_BAR();
    {
        PTRS();
        pg8::Gemm g{H, WT1, DM, DM, DM, 0, (size_t)256 * DM * 2}; pg8::StaticOrder S; S.init(MTOK, N_IN1, G, bx);
        pg8::EpiQKVG E{QKVG, KC, VC, k_gain, (__attribute__((address_space(3))) float*)(lds3 + 131072 + 512)};
        pg8::gemm_phase<pg8::EpiQKVG, pg8::StaticOrder, true, true>(lds3, g, S, E, wave_s);
    }
    GRID_BAR();
    {
        PTRS();
        constexpr int NUNITS = BATCH * 16 * (SEQ / 256);
        const float Braw = MOD[49152]; const bool fast = Braw * att::SCALE <= 40.f; const float negBC = -Braw * att::SCALE * 1.4426950408889634f;
        if (fast) {
        for (int i = 0; i * G + bx < NUNITS; ++i) {
            int b, h, qb;
            if (G == 256) { const int xc = bx & 7, j = bx >> 3, pair = 2 * xc + (i >> 2); b = pair >> 2; h = (pair & 3) * 4 + (i & 3); qb = j; }
            else { const int uu = i * G + bx; qb = uu & 31; h = (uu >> 5) & 15; b = uu >> 9; }
            const int kvh = h >> 2; int lane_a = lane_id(); asm volatile("" : "+v"(lane_a));
            const size_t qrow = (size_t)(b * SEQ + qb * 256) * 5120, kvo = ((size_t)(b * 4 + kvh)) * SEQ * 128;
att::attn_dense_body<true>(QKVG + qrow + h * 128, KC + kvo, VC + kvo, QKVG + qrow + 3072 + h * 128,
                                 OG + (size_t)(b * SEQ + qb * 256) * 2048 + h * 128, q_gain, qb * 256, negBC, SEQ, (char*)lds, wave_s, lane_a);
            __syncthreads();
        }
        } else {
        for (int i = 0; i * G + bx < NUNITS; ++i) {
            int b, h, qb;
            if (G == 256) { const int xc = bx & 7, j = bx >> 3, pair = 2 * xc + (i >> 2); b = pair >> 2; h = (pair & 3) * 4 + (i & 3); qb = j; }
            else { const int uu = i * G + bx; qb = uu & 31; h = (uu >> 5) & 15; b = uu >> 9; }
            const int kvh = h >> 2; int lane_a = lane_id(); asm volatile("" : "+v"(lane_a));
            const size_t qrow = (size_t)(b * SEQ + qb * 256) * 5120, kvo = ((size_t)(b * 4 + kvh)) * SEQ * 128;
att::attn_dense_body<false>(QKVG + qrow + h * 128, KC + kvo, VC + kvo, QKVG + qrow + 3072 + h * 128,
                                 OG + (size_t)(b * SEQ + qb * 256) * 2048 + h * 128, q_gain, qb * 256, 0.f, SEQ, (char*)lds, wave_s, lane_a);
            __syncthreads();
        }
        }
    }
    GRID_BAR();
    {
        PTRS();
        pg8::Gemm g{OG, WT2, DM, DM, DM, 0, (size_t)256 * DM * 2}; pg8::StaticOrder S; S.init(MTOK, DM, G, bx);
        pg8::EpiResid1 E{x, X1, MOD + 4096};
        pg8::gemm_phase<pg8::EpiResid1, pg8::StaticOrder, true, true>(lds3, g, S, E, wave_s);
    }
    GRID_BAR();
    { PHASE_IDS(); PTRS(); norm_mod_rows<bf16, true>(X1, norm_g + DM, MOD + 4 * 6144, H, gw, NGW, lane); }
    GRID_BAR();
    {
        PTRS();
        static_assert(WS_WT3 == 28 * MiB && WS_H == 320 * MiB && (size_t)256 * DM * 2 == MiB, "virtual tile indices of the DualOrder stream");
        pg8::Gemm g{(const bf16*)ws, (const bf16*)ws, DM, DM, DM, 0, (size_t)256 * DM * 2};
        pg8::DualOrder S; S.init(DM, MTOK, MTOK, DM, G, bx, 28, 320, 320, 36);
        pg8::EpiUTSG E{{UT}, {SG}};
        pg8::gemm_phase<pg8::EpiUTSG, pg8::DualOrder, true, true>(lds3, g, S, E, wave_s);
    }
    GRID_BAR();
    {
        PTRS();
        pg8::Gemm g{FW1, UT, 128, 128, 128, 0, (size_t)256 * 128 * 2}; pg8::StaticOrder S; S.init(256, BATCH * DM * 64, G, bx);
        pg8::EpiFft1 E{TP};
        pg8::gemm_phase<pg8::EpiFft1, pg8::StaticOrder, true, true>(lds3, g, S, E, wave_s);
    }
    GRID_BAR();
    {
        PTRS();
        pg8::Gemm g{FW2, TP, 128, 128, 128, 0, (size_t)256 * 128 * 2}; pg8::StaticOrder S; S.init(256, BATCH * 128 * DM, G, bx);
        pg8::EpiFft2 E{Z};
        pg8::gemm_phase<pg8::EpiFft2, pg8::StaticOrder, true, true, true>(lds3, g, S, E, wave_s);
    }
    GRID_BAR();
    {
        PTRS();
        pg8::Gemm g{Z, DFTC, 4096, 512, 512, (size_t)512 * 2, 0}; pg8::StaticOrder S; S.init(MTOK, DM, G, bx);
        pg8::EpiDftC E{SG, FG, 6.9053396600248786e-4f};
        pg8::gemm_phase<pg8::EpiDftC, pg8::StaticOrder, true, true>(lds3, g, S, E, wave_s);
    }
    GRID_BAR();
    {
        PTRS();
        pg8::Gemm g{FG, WT4, DM, DM, DM, 0, (size_t)256 * DM * 2}; pg8::StaticOrder S; S.init(MTOK, DM, G, bx);
        pg8::EpiResid2 E{X1, MOD + 4 * 6144 + 4096};
        pg8::gemm_phase<pg8::EpiResid2, pg8::StaticOrder, true, true>(lds3, g, S, E, wave_s);
    }
    GRID_BAR();
    { PHASE_IDS(); PTRS();
    for (int row = gw; row < MTOK; row += NGW) { float* rp = out + (size_t)row * DM + lane * 4; const bf16* xp = X1 + (size_t)row * DM + lane * 4;
        f32x4 v[8]; float ss = 0.f;
#pragma unroll
        for (int j = 0; j < 8; ++j) { v[j] = ld4f(xp + 256 * j); ss += (v[j].x * v[j].x + v[j].y * v[j].y) + (v[j].z * v[j].z + v[j].w * v[j].w); }
        const float rstd = rsqrtf(wave_sum(ss) * (1.f / DM) + 1e-6f);
#pragma unroll
        for (int j = 0; j < 8; ++j) *(f32x4*)(rp + 256 * j) = v[j] * rstd * *(const f32x4*)(final_g + lane * 4 + 256 * j); } }
}

extern "C" void kernel_launch(void* const* d_in, const int* in_sizes, int n_in, void* d_out, int out_size, void* d_ws, size_t ws_size, hipStream_t stream) {
    static int grid_blocks = 0;
    if (grid_blocks == 0) {
        if (n_in != 12 || in_sizes[0] != MTOK * DM || out_size != MTOK * DM || ws_size < WS_END) {
            fprintf(stderr, "kernel_launch: shape mismatch n_in %d in0 %d out %d ws %zu (need %zu)\n", n_in, n_in > 0 ? in_sizes[0] : -1, out_size, ws_size, (size_t)WS_END); grid_blocks = -1; return; }
        int dev = 0, cus = 0, per_cu = 0;
        hipGetDevice(&dev);
        hipDeviceGetAttribute(&cus, hipDeviceAttributeMultiprocessorCount, dev);
        if (hipFuncSetAttribute((const void*)fwd_megakernel, hipFuncAttributeMaxDynamicSharedMemorySize, LDS_BYTES) != hipSuccess) { fprintf(stderr, "kernel_launch: hipFuncSetAttribute failed\n"); grid_blocks = -1; return; }
        if (hipOccupancyMaxActiveBlocksPerMultiprocessor(&per_cu, (const void*)fwd_megakernel, NTHR, LDS_BYTES) != hipSuccess || per_cu < 1) { fprintf(stderr, "kernel_launch: occupancy query gave %d\n", per_cu); per_cu = 1; }
        (void)hipGetLastError();
        grid_blocks = cus * per_cu;
    }
    if (grid_blocks < 0) return;
    Args a{};
    for (int i = 0; i < 12; ++i) a.in[i] = (const float*)d_in[i];
    a.out = (float*)d_out; a.ws = (unsigned char*)d_ws;
    void* kargs[] = {&a};
    hipError_t e = hipLaunchCooperativeKernel((const void*)fwd_megakernel, dim3(grid_blocks), dim3(NTHR), kargs, LDS_BYTES, stream);
    if (e != hipSuccess) fprintf(stderr, "cooperative launch failed: %s (grid %d)\n", hipGetErrorString(e), grid_blocks);
}
```

```cpp
#include <hip/hip_runtime.h>
#include <hip/hip_cooperative_groups.h>
#include <cstdio>
#include <cstdint>
namespace cg = cooperative_groups;

__device__ __forceinline__ unsigned short f2bf_rne(float f) { unsigned u = __builtin_bit_cast(unsigned, f); return (unsigned short)((u + 0x7fffu + ((u >> 16) & 1u)) >> 16); }
__device__ __forceinline__ float bf2f(unsigned short h) { return __builtin_bit_cast(float, (unsigned)h << 16); }
__device__ __forceinline__ int lane_id() { return (int)__builtin_amdgcn_mbcnt_hi(~0u, __builtin_amdgcn_mbcnt_lo(~0u, 0u)); }
__device__ __forceinline__ float silu_f(float g) { return g * __builtin_amdgcn_rcpf(1.f + __expf(-g)); }

namespace pg8 {
#define PG8_LAS __attribute__((address_space(3)))
typedef unsigned short bf16_t;
typedef short bf16x8 __attribute__((ext_vector_type(8)));
typedef float f32x4 __attribute__((ext_vector_type(4)));
typedef unsigned u32x4 __attribute__((ext_vector_type(4)));
typedef unsigned u32x2 __attribute__((ext_vector_type(2)));
constexpr int BM = 256, BK = 64, HALF = 128, HTB = HALF * BK * 2  , STAGE_BYTES = 8 * HTB, NXCD = 8, WGM = 4;

__host__ __device__ __forceinline__ int lds_byte(int r, int c) { const int st = (r >> 4) * 2 + (c >> 5), rr = r & 15, cc = c & 31, ob = rr * 64 + cc * 2; return st * 1024 + (ob ^ (((ob >> 9) & 1) << 5)); }
__host__ __device__ __forceinline__ void stage_rc(int b, int& R, int& C) { const int st = b / 1024, sb = b % 1024, swz = sb ^ (((sb >> 9) & 1) << 5); R = (st >> 1) * 16 + swz / 64; C = (st & 1) * 32 + (swz % 64) / 2; }
__host__ __device__ __forceinline__ int perm32(int rho) { const int n = rho >> 4, i = rho & 15; return 8 * (i >> 2) + 4 * n + (i & 3); }

struct Unit { int pm, pn; };
struct Gemm { const bf16_t* A; const bf16_t* Bt; int lda, ldb, K; size_t a_pn_off, b_pn_step; };

struct StaticOrder {
    int nM, nN, nwg, G, c;
    __host__ __device__ void init(int M, int N, int G_, int c_) { nM = M / BM; nN = N / BM; nwg = nM * nN; G = G_; c = c_; }
    __host__ __device__ bool next(int i, Unit& u) const {
        const long L = (long)i * G + c; if (L >= nwg) return false;
        int wgid = (int)L; { const int q = nwg / NXCD, r = nwg % NXCD, xcd = wgid % NXCD, off = wgid / NXCD; wgid = (xcd < r ? xcd * (q + 1) : r * (q + 1) + (xcd - r) * q) + off; }
        const int nig = WGM * nN, gid = wgid / nig, fm = gid * WGM, gsz = (nM - fm) < WGM ? (nM - fm) : WGM;
        u.pm = fm + ((wgid % nig) % gsz); u.pn = (wgid % nig) / gsz; return true;
    }
    __device__ __forceinline__ void a_ready(const Unit&) const {}
    __device__ __forceinline__ void done(const Unit&) const {}
};

struct DualOrder {
    StaticOrder S1, S2; int n1, a1, b1, a2, b2;
    __host__ __device__ void init(int M1, int N1, int M2, int N2, int G, int c, int a1_, int b1_, int a2_, int b2_) {
        S1.init(M1, N1, G, c); S2.init(M2, N2, G, c); n1 = (c < S1.nwg) ? (S1.nwg - c + G - 1) / G : 0; a1 = a1_; b1 = b1_; a2 = a2_; b2 = b2_; }
    __host__ __device__ bool next(int i, Unit& u) const {
        if (i < n1) { if (!S1.next(i, u)) return false; u.pm += a1; u.pn += b1; return true; }
        if (!S2.next(i - n1, u)) return false; u.pm += a2; u.pn += b2; return true; }
    __device__ __forceinline__ void a_ready(const Unit&) const {}
    __device__ __forceinline__ void done(const Unit&) const {}
};

__device__ __forceinline__ unsigned cvt_pk_bf16(float lo, float hi) { unsigned r; asm volatile("v_cvt_pk_bf16_f32 %0, %1, %2" : "=v"(r) : "v"(lo), "v"(hi)); return r; }
__device__ __forceinline__ u32x4 pack8(f32x4 v0, f32x4 v1) { u32x4 w; w.x = cvt_pk_bf16(v0[0], v0[1]); w.y = cvt_pk_bf16(v0[2], v0[3]); w.z = cvt_pk_bf16(v1[0], v1[1]); w.w = cvt_pk_bf16(v1[2], v1[3]); return w; }
__device__ __forceinline__ float silu1(float g) { return g * __builtin_amdgcn_rcpf(1.f + __expf(-g)); }
__device__ __forceinline__ f32x4 silu4(f32x4 v) { return (f32x4){silu1(v[0]), silu1(v[1]), silu1(v[2]), silu1(v[3])}; }
__device__ __forceinline__ float bfl(unsigned w) { return __builtin_bit_cast(float, w << 16); }
__device__ __forceinline__ float bfh(unsigned w) { return __builtin_bit_cast(float, w & 0xffff0000u); }

struct EpiPlain {
    static constexpr bool PERM = true, AFTER_DRAIN = false;
    bf16_t* O; int ldc;
    __device__ __forceinline__ void operator()(const f32x4 (&acc)[2][2][4][2], const Unit& u, int wr, int wc, int fr, int fq) const {
        const int row0 = u.pm * BM + wr * 64 + fr, col0 = u.pn * BM + wc * 32 + 8 * fq;
#pragma unroll
        for (int ai = 0; ai < 2; ++ai)
#pragma unroll
            for (int m = 0; m < 4; ++m) { bf16_t* rowp = O + (size_t)(row0 + ai * HALF + m * 16) * ldc + col0;
#pragma unroll
                for (int bj = 0; bj < 2; ++bj) *(u32x4*)(rowp + bj * HALF) = pack8(acc[ai][bj][m][0], acc[ai][bj][m][1]); }
    }
};
struct EpiQKVG {
    static constexpr bool PERM = true, AFTER_DRAIN = false;
    bf16_t* O; bf16_t* KC; bf16_t* VC; const float* kg; PG8_LAS float* scr;
    __device__ __forceinline__ void operator()(const f32x4 (&acc)[2][2][4][2], const Unit& u, int wr, int wc, int fr, int fq) const {
        const int rl0 = wr * 64 + fr, colw = wc * 32 + 8 * fq;
        if (u.pn < 8 || u.pn >= 12) {
            const int row0 = u.pm * BM + rl0, col0 = u.pn * BM + colw;
#pragma unroll
            for (int ai = 0; ai < 2; ++ai)
#pragma unroll
                for (int m = 0; m < 4; ++m) { bf16_t* rowp = O + (size_t)(row0 + ai * HALF + m * 16) * 5120 + col0;
#pragma unroll
                    for (int bj = 0; bj < 2; ++bj) { f32x4 v0 = acc[ai][bj][m][0], v1 = acc[ai][bj][m][1];
                        if (u.pn >= 12) { v0 = silu4(v0); v1 = silu4(v1); }
                        *(u32x4*)(rowp + bj * HALF) = pack8(v0, v1); } }
            return;
        }
        const int b = u.pm >> 5, t0 = (u.pm & 31) * BM + rl0;
        if (u.pn >= 10) {
            const int h0 = (u.pn - 10) * 2;
#pragma unroll
            for (int ai = 0; ai < 2; ++ai)
#pragma unroll
                for (int m = 0; m < 4; ++m)
#pragma unroll
                    for (int bj = 0; bj < 2; ++bj)
                        *(u32x4*)(VC + (((size_t)(b * 4 + h0 + bj)) * 8192 + t0 + ai * HALF + m * 16) * 128 + colw) = pack8(acc[ai][bj][m][0], acc[ai][bj][m][1]);
            return;
        }
        const int h0 = (u.pn - 8) * 2;
#pragma unroll
        for (int ai = 0; ai < 2; ++ai)
#pragma unroll
            for (int m = 0; m < 4; ++m)
#pragma unroll
                for (int bj = 0; bj < 2; ++bj) { const f32x4 a = acc[ai][bj][m][0], c = acc[ai][bj][m][1];
                    float ss = (a[0] * a[0] + a[1] * a[1]) + (a[2] * a[2] + a[3] * a[3]) + (c[0] * c[0] + c[1] * c[1]) + (c[2] * c[2] + c[3] * c[3]);
                    ss += __builtin_bit_cast(float, __builtin_amdgcn_ds_swizzle(__builtin_bit_cast(int, ss), (16 << 10) | 0x1f));
                    { float x = ss, y = ss; asm volatile("s_nop 1\n\tv_permlane32_swap_b32 %0, %1\n\ts_nop 1" : "+v"(x), "+v"(y)); ss = x + y; }
                    if (fq == 0) scr[((wc * 256 + ai * HALF + m * 16 + rl0) * 2) + bj] = ss; }
        asm volatile("s_waitcnt lgkmcnt(0)" ::: "memory"); __builtin_amdgcn_s_barrier();
        float rstd[2][4][2];
#pragma unroll
        for (int ai = 0; ai < 2; ++ai)
#pragma unroll
            for (int m = 0; m < 4; ++m) { const int r = ai * HALF + m * 16 + rl0;
                typedef float f32x2_t __attribute__((ext_vector_type(2)));
                const f32x2_t s0 = *(const PG8_LAS f32x2_t*)(scr + (0 * 256 + r) * 2), s1 = *(const PG8_LAS f32x2_t*)(scr + (1 * 256 + r) * 2),
                              s2 = *(const PG8_LAS f32x2_t*)(scr + (2 * 256 + r) * 2), s3 = *(const PG8_LAS f32x2_t*)(scr + (3 * 256 + r) * 2);
                rstd[ai][m][0] = __builtin_amdgcn_rsqf(((s0.x + s1.x) + (s2.x + s3.x)) * (1.f / 128.f) + 1e-6f);
                rstd[ai][m][1] = __builtin_amdgcn_rsqf(((s0.y + s1.y) + (s2.y + s3.y)) * (1.f / 128.f) + 1e-6f); }
        asm volatile("s_waitcnt lgkmcnt(0)" ::: "memory"); __builtin_amdgcn_s_barrier();
        const f32x4 g0 = *(const f32x4*)(kg + colw), g1 = *(const f32x4*)(kg + colw + 4);
        float invf[4];
#pragma unroll
        for (int q = 0; q < 4; ++q) invf[q] = exp2f(-(float)(16 * (wc & 1) + 4 * fq + q) * (13.287712379549449f / 32.f)) * 0.15915494309189535f;
#pragma unroll
        for (int ai = 0; ai < 2; ++ai)
#pragma unroll
            for (int m = 0; m < 4; ++m) { int t = t0 + ai * HALF + m * 16; asm volatile("" : "+v"(t));
                const float pos = (float)((wc < 2) ? (t >> 6) : (t & 63));
                float cs[4], sn[4];
#pragma unroll
                for (int q = 0; q < 4; ++q) { float xr = pos * invf[q]; xr -= floorf(xr); cs[q] = __builtin_amdgcn_cosf(xr); sn[q] = __builtin_amdgcn_sinf(xr); }
#pragma unroll
                for (int bj = 0; bj < 2; ++bj) { const f32x4 y0 = acc[ai][bj][m][0] * rstd[ai][m][bj] * g0, y1 = acc[ai][bj][m][1] * rstd[ai][m][bj] * g1;
                    u32x4 w;
                    w.x = cvt_pk_bf16(y0[0] * cs[0] - y0[1] * sn[0], y0[0] * sn[0] + y0[1] * cs[0]);
                    w.y = cvt_pk_bf16(y0[2] * cs[1] - y0[3] * sn[1], y0[2] * sn[1] + y0[3] * cs[1]);
                    w.z = cvt_pk_bf16(y1[0] * cs[2] - y1[1] * sn[2], y1[0] * sn[2] + y1[1] * cs[2]);
                    w.w = cvt_pk_bf16(y1[2] * cs[3] - y1[3] * sn[3], y1[2] * sn[3] + y1[3] * cs[3]);
                    *(u32x4*)(KC + (((size_t)(b * 4 + h0 + bj)) * 8192 + t) * 128 + colw) = w; }
                __builtin_amdgcn_sched_barrier(0); }
    }
};
struct EpiUT {
    static constexpr bool PERM = true, AFTER_DRAIN = false;
    bf16_t* UT;
    __device__ __forceinline__ void operator()(const f32x4 (&acc)[2][2][4][2], const Unit& u, int wr, int wc, int fr, int fq) const {
        const int b = u.pn >> 5, p0 = (u.pn & 31) * BM + wc * 32 + 8 * fq, c0 = u.pm * BM + wr * 64 + fr;
#pragma unroll
        for (int ai = 0; ai < 2; ++ai)
#pragma unroll
            for (int m = 0; m < 4; ++m) { bf16_t* rowp = UT + ((size_t)(b * 2048 + c0 + ai * HALF + m * 16)) * 8192 + p0;
#pragma unroll
                for (int bj = 0; bj < 2; ++bj) *(u32x4*)(rowp + bj * HALF) = pack8(acc[ai][bj][m][0], acc[ai][bj][m][1]); }
    }
};
struct EpiSGperm {
    static constexpr bool PERM = true, AFTER_DRAIN = false;
    bf16_t* SG;
    __device__ __forceinline__ void operator()(const f32x4 (&acc)[2][2][4][2], const Unit& u, int wr, int wc, int fr, int fq) const {
        const int b = u.pm >> 5, p0 = (u.pm & 31) * BM + wr * 64 + fr, col0 = u.pn * BM + wc * 32 + 8 * fq;
#pragma unroll
        for (int ai = 0; ai < 2; ++ai)
#pragma unroll
            for (int m = 0; m < 4; ++m) { const int p = p0 + ai * HALF + m * 16, n = (p & 127) * 64 + (p >> 7);
                bf16_t* rowp = SG + (size_t)(b * 8192 + n) * 2048 + col0;
#pragma unroll
                for (int bj = 0; bj < 2; ++bj) *(u32x4*)(rowp + bj * HALF) = pack8(silu4(acc[ai][bj][m][0]), silu4(acc[ai][bj][m][1])); }
    }
};
struct EpiUTSG {
    static constexpr bool PERM = true, AFTER_DRAIN = false;
    EpiUT E1; EpiSGperm E2;
    __device__ __forceinline__ void operator()(const f32x4 (&acc)[2][2][4][2], const Unit& u, int wr, int wc, int fr, int fq) const {
        if (u.pm < 320) { const Unit v{u.pm - 28, u.pn - 320}; E1(acc, v, wr, wc, fr, fq); }
        else            { const Unit v{u.pm - 320, u.pn - 36}; E2(acc, v, wr, wc, fr, fq); }
    }
};
struct EpiResid1 {
    static constexpr bool PERM = true, AFTER_DRAIN = false;
    const float* res; bf16_t* out; const float* gate;
    __device__ __forceinline__ void operator()(const f32x4 (&acc)[2][2][4][2], const Unit& u, int wr, int wc, int fr, int fq) const {
        const int row0 = u.pm * BM + wr * 64 + fr, col0 = u.pn * BM + wc * 32 + 8 * fq;
        const float* gb = gate + (size_t)(u.pm / 32) * 6144 + col0;
        f32x4 gv[2][2];
#pragma unroll
        for (int bj = 0; bj < 2; ++bj)
#pragma unroll
            for (int n = 0; n < 2; ++n) gv[bj][n] = *(const f32x4*)(gb + bj * HALF + 4 * n);
#pragma unroll
        for (int ai = 0; ai < 2; ++ai)
#pragma unroll
            for (int m = 0; m < 4; ++m) { const size_t off = (size_t)(row0 + ai * HALF + m * 16) * 2048 + col0;
#pragma unroll
                for (int bj = 0; bj < 2; ++bj) { const f32x4 x0 = *(const f32x4*)(res + off + bj * HALF), x1 = *(const f32x4*)(res + off + bj * HALF + 4);
                    *(u32x4*)(out + off + bj * HALF) = pack8(x0 + gv[bj][0] * acc[ai][bj][m][0], x1 + gv[bj][1] * acc[ai][bj][m][1]); } }
    }
};
struct EpiResid2 {
    static constexpr bool PERM = true, AFTER_DRAIN = false;
    bf16_t* xio; const float* gate;
    __device__ __forceinline__ void operator()(const f32x4 (&acc)[2][2][4][2], const Unit& u, int wr, int wc, int fr, int fq) const {
        const int row0 = u.pm * BM + wr * 64 + fr, col0 = u.pn * BM + wc * 32 + 8 * fq;
        const float* gb = gate + (size_t)(u.pm / 32) * 6144 + col0;
        f32x4 gv[2][2];
#pragma unroll
        for (int bj = 0; bj < 2; ++bj)
#pragma unroll
            for (int n = 0; n < 2; ++n) gv[bj][n] = *(const f32x4*)(gb + bj * HALF + 4 * n);
#pragma unroll
        for (int ai = 0; ai < 2; ++ai)
#pragma unroll
            for (int m = 0; m < 4; ++m) { const size_t off = (size_t)(row0 + ai * HALF + m * 16) * 2048 + col0;
#pragma unroll
                for (int bj = 0; bj < 2; ++bj) { const u32x4 s = *(const u32x4*)(xio + off + bj * HALF);
                    const f32x4 x0 = {bfl(s.x), bfh(s.x), bfl(s.y), bfh(s.y)}, x1 = {bfl(s.z), bfh(s.z), bfl(s.w), bfh(s.w)};
                    *(u32x4*)(xio + off + bj * HALF) = pack8(x0 + gv[bj][0] * acc[ai][bj][m][0], x1 + gv[bj][1] * acc[ai][bj][m][1]); } }
    }
};
struct EpiFft1 {
    static constexpr bool PERM = true, AFTER_DRAIN = false;
    bf16_t* T;
    __device__ __forceinline__ void operator()(const f32x4 (&acc)[2][2][4][2], const Unit& u, int wr, int wc, int fr, int fq) const {
        const int b = u.pn >> 9, c0 = (u.pn & 511) * 4 + (wc >> 1), n2b = 32 * (wc & 1) + 8 * fq;
#pragma unroll
        for (int m = 0; m < 4; ++m) { int k1 = wr * 64 + m * 16 + fr; asm volatile("" : "+v"(k1));
            bf16_t* p = T + (((size_t)(b * 128 + k1)) * 2048 + c0) * 128 + n2b;
            f32x4 cv[2], sv[2];
#pragma unroll
            for (int n = 0; n < 2; ++n)
#pragma unroll
                for (int j = 0; j < 4; ++j) { const float xr = (float)(((n2b + 4 * n + j) * k1) & 8191) * (1.f / 8192.f); cv[n][j] = __builtin_amdgcn_cosf(xr); sv[n][j] = __builtin_amdgcn_sinf(xr); }
#pragma unroll
            for (int bj = 0; bj < 2; ++bj) { const f32x4 r0 = acc[0][bj][m][0], r1 = acc[0][bj][m][1], i0 = acc[1][bj][m][0], i1 = acc[1][bj][m][1];
                *(u32x4*)(p + bj * 256) = pack8(r0 * cv[0] + i0 * sv[0], r1 * cv[1] + i1 * sv[1]);
                *(u32x4*)(p + bj * 256 + 64) = pack8(i0 * cv[0] - r0 * sv[0], i1 * cv[1] - r1 * sv[1]); }
            __builtin_amdgcn_sched_barrier(0); }
    }
};
struct EpiFft2 {
    static constexpr bool PERM = true, AFTER_DRAIN = false;
    bf16_t* Z;
    __device__ __forceinline__ void operator()(const f32x4 (&acc)[2][2][4][2], const Unit& u, int wr, int wc, int fr, int fq) const {
        const int b = u.pn >> 10, k1 = (u.pn >> 3) & 127, g = u.pn & 7;
        const int col0 = g * 512 + wr * 256 + wc * 32 + 8 * fq;
#pragma unroll
        for (int m = 0; m < 4; ++m) { const int k2 = m * 16 + fr; bf16_t* rowp = Z + (size_t)(b * 8192 + k1 + 128 * k2) * 4096 + col0;
#pragma unroll
            for (int bj = 0; bj < 2; ++bj) *(u32x4*)(rowp + bj * HALF) = pack8(acc[0][bj][m][0], acc[0][bj][m][1]); }
    }
};
struct EpiDftC {
    static constexpr bool PERM = true, AFTER_DRAIN = false;
    const bf16_t* SG; bf16_t* FG; float norm;
    __device__ __forceinline__ void operator()(const f32x4 (&acc)[2][2][4][2], const Unit& u, int wr, int wc, int fr, int fq) const {
        const int row0 = u.pm * BM + wr * 64 + fr, col0 = u.pn * BM + wc * 32 + 8 * fq;
#pragma unroll
        for (int ai = 0; ai < 2; ++ai)
#pragma unroll
            for (int m = 0; m < 4; ++m) { const size_t off = (size_t)(row0 + ai * HALF + m * 16) * 2048 + col0;
#pragma unroll
                for (int bj = 0; bj < 2; ++bj) { const u32x4 s = *(const u32x4*)(SG + off + bj * HALF);
                    f32x4 v0 = acc[ai][bj][m][0] * norm, v1 = acc[ai][bj][m][1] * norm;
                    v0 = v0 * (f32x4){bfl(s.x), bfh(s.x), bfl(s.y), bfh(s.y)}; v1 = v1 * (f32x4){bfl(s.z), bfh(s.z), bfl(s.w), bfh(s.w)};
                    *(u32x4*)(FG + off + bj * HALF) = pack8(v0, v1); } }
    }
};

template <class Epi, class Sched, bool ALIGN_EPI = false, bool SP2 = false>
__device__ __forceinline__ void gemm_phase(PG8_LAS unsigned char* lds, const Gemm g, const Sched& S, const Epi& E, const int wid_s) {
    int lane_l = lane_id(); asm volatile("" : "+v"(lane_l));
    const int wid = wid_s, lane = lane_l, tid = wid * 64 + lane, wr = wid >> 2, wc = wid & 3, fr = lane & 15, fq = lane >> 4;
    int K_l = g.K; asm volatile("" : "+s"(K_l)); const int K = K_l, nt = K / BK;
    unsigned voffA[2], voffB[2];
#pragma unroll
    for (int i = 0; i < 2; ++i) { int R, C; stage_rc(tid * 16 + i * 8192, R, C); const int Rb = Epi::PERM ? ((R & ~31) + perm32(R & 31)) : R;
        voffA[i] = (unsigned)(R * g.lda + C) * 2u; voffB[i] = (unsigned)(Rb * g.ldb + C) * 2u; }
    const size_t kstep = (size_t)(BK * 2);
    const size_t hstepA = (size_t)HALF * g.lda * 2, hstepB = (size_t)HALF * g.ldb * 2;
    const size_t tstepA = 2 * hstepA;
    const unsigned ldsw = (unsigned)wid * 1024u;
    const int aoff = lds_byte(wr * 64 + fr, fq * 8), boff = lds_byte(wc * 32 + fr, fq * 8);
#define PG8_SA(b, h) (((b) * 2 + (h)) * HTB)
#define PG8_SB(b, h) ((4 + (b) * 2 + (h)) * HTB)
#define PG8_STAGE(bufoff, gbase, voff) do { _Pragma("unroll") for (int _i = 0; _i < 2; ++_i) \
        __builtin_amdgcn_global_load_lds((const unsigned*)((const char*)(gbase) + (voff)[_i]), (PG8_LAS unsigned*)(lds + (bufoff) + ldsw + _i * 8192), 16, 0, 0); } while (0)
#define PG8_LDA(dst, b, h) do { _Pragma("unroll") for (int m = 0; m < 4; ++m) _Pragma("unroll") for (int k = 0; k < 2; ++k) dst[m][k] = *(const PG8_LAS bf16x8*)(lds + PG8_SA(b, h) + aoff + m * 2048 + k * 1024); } while (0)
#define PG8_LDB(dst, b, h) do { _Pragma("unroll") for (int n = 0; n < 2; ++n) _Pragma("unroll") for (int k = 0; k < 2; ++k) dst[n][k] = *(const PG8_LAS bf16x8*)(lds + PG8_SB(b, h) + boff + n * 2048 + k * 1024); } while (0)
#define PG8_MMA(ai, bj, At, Bt) do { __builtin_amdgcn_s_setprio(1); _Pragma("unroll") for (int m = 0; m < 4; ++m) _Pragma("unroll") for (int n = 0; n < 2; ++n) _Pragma("unroll") for (int k = 0; k < 2; ++k) \
        acc[ai][bj][m][n] = __builtin_amdgcn_mfma_f32_16x16x32_bf16(Bt[n][k], At[m][k], acc[ai][bj][m][n], 0, 0, 0); __builtin_amdgcn_s_setprio(0); } while (0)
#define PG8_WAIT_V(n) asm volatile("s_waitcnt vmcnt(" #n ")" ::: "memory")
#define PG8_WAIT_L(n) asm volatile("s_waitcnt lgkmcnt(" #n ")" ::: "memory")
#define PG8_BAR __builtin_amdgcn_s_barrier()
#define PG8_SCHED __builtin_amdgcn_sched_barrier(0)
    Unit cur, nxt; int ui = 0;
    if (!S.next(0, cur)) return;
    f32x4 acc[2][2][4][2];
#pragma unroll
    for (int a = 0; a < 2; ++a)
#pragma unroll
        for (int b = 0; b < 2; ++b)
#pragma unroll
            for (int m = 0; m < 4; ++m)
#pragma unroll
                for (int n = 0; n < 2; ++n) acc[a][b][m][n] = (f32x4){0.f, 0.f, 0.f, 0.f};
    bf16x8 At[4][2], B0[2][2], B1[2][2];
    const char* cA = (const char*)g.A + (size_t)cur.pm * tstepA + (size_t)cur.pn * g.a_pn_off; const char* cB = (const char*)g.Bt + (size_t)cur.pn * g.b_pn_step;
    S.a_ready(cur);
    if constexpr (SP2) {
        PG8_STAGE(PG8_SB(0, 0), cB, voffB); PG8_STAGE(PG8_SB(0, 1), cB + hstepB, voffB); PG8_STAGE(PG8_SA(0, 0), cA, voffA); PG8_STAGE(PG8_SA(0, 1), cA + hstepA, voffA);
        if (wr == 1) PG8_BAR;
        PG8_WAIT_V(2); PG8_BAR;
        PG8_STAGE(PG8_SB(1, 0), cB + kstep, voffB); PG8_STAGE(PG8_SA(1, 0), cA + kstep, voffA); PG8_STAGE(PG8_SB(1, 1), cB + hstepB + kstep, voffB);
        PG8_WAIT_V(6); PG8_BAR;
    } else {
        PG8_STAGE(PG8_SB(0, 0), cB, voffB); PG8_STAGE(PG8_SA(0, 0), cA, voffA); PG8_STAGE(PG8_SB(0, 1), cB + hstepB, voffB); PG8_STAGE(PG8_SA(0, 1), cA + hstepA, voffA);
        if (wr == 1) PG8_BAR;
        PG8_WAIT_V(4); PG8_BAR;
        PG8_STAGE(PG8_SB(1, 0), cB + kstep, voffB); PG8_STAGE(PG8_SA(1, 0), cA + kstep, voffA); PG8_STAGE(PG8_SB(1, 1), cB + hstepB + kstep, voffB);
        PG8_WAIT_V(6); PG8_BAR;
    }
    for (;;) {
        const bool has_next = S.next(ui + 1, nxt);
        const char* nA = has_next ? (const char*)g.A + (size_t)nxt.pm * tstepA + (size_t)nxt.pn * g.a_pn_off : cA; const char* nB = has_next ? (const char*)g.Bt + (size_t)nxt.pn * g.b_pn_step : cB;
        for (int t = 0; t < nt; t += 2) {
            const bool last = (t == nt - 2);
            const char* a1 = cA + (size_t)(t + 1) * kstep;
            const char* a2 = last ? nA : cA + (size_t)(t + 2) * kstep; const char* b2 = last ? nB : cB + (size_t)(t + 2) * kstep;
            const char* a3 = a2 + kstep; const char* b3 = b2 + kstep;
            if (last && has_next) S.a_ready(nxt);
            if constexpr (SP2) {
            PG8_LDB(B0, 0, 0); PG8_LDB(B1, 0, 1); PG8_SCHED; PG8_LDA(At, 0, 0); PG8_STAGE(PG8_SA(1, 1), a1 + hstepA, voffA);
            PG8_WAIT_V(8); PG8_WAIT_L(0); PG8_BAR; PG8_MMA(0, 0, At, B0); PG8_MMA(0, 1, At, B1); PG8_BAR; PG8_SCHED;
            PG8_LDA(At, 0, 1); PG8_STAGE(PG8_SB(0, 0), b2, voffB); PG8_STAGE(PG8_SB(0, 1), b2 + hstepB, voffB); PG8_STAGE(PG8_SA(0, 0), a2, voffA);
            PG8_WAIT_V(8); PG8_WAIT_L(0); PG8_BAR; PG8_MMA(1, 0, At, B0); PG8_MMA(1, 1, At, B1); PG8_BAR; PG8_SCHED;
            PG8_LDB(B0, 1, 0); PG8_LDB(B1, 1, 1); PG8_SCHED; PG8_LDA(At, 1, 0); PG8_STAGE(PG8_SA(0, 1), a2 + hstepA, voffA);
            PG8_WAIT_V(8); PG8_WAIT_L(0); PG8_BAR; PG8_MMA(0, 0, At, B0); PG8_MMA(0, 1, At, B1); PG8_BAR; PG8_SCHED;
            PG8_LDA(At, 1, 1); PG8_STAGE(PG8_SB(1, 0), b3, voffB); PG8_STAGE(PG8_SB(1, 1), b3 + hstepB, voffB); PG8_STAGE(PG8_SA(1, 0), a3, voffA);
            PG8_WAIT_V(8); PG8_WAIT_L(0); PG8_BAR; PG8_MMA(1, 0, At, B0); PG8_MMA(1, 1, At, B1); PG8_BAR; PG8_SCHED;
            } else {
            PG8_LDB(B0, 0, 0); PG8_SCHED; PG8_LDA(At, 0, 0); PG8_STAGE(PG8_SA(1, 1), a1 + hstepA, voffA);
            PG8_WAIT_L(8); PG8_BAR; PG8_WAIT_L(0); PG8_MMA(0, 0, At, B0); PG8_BAR; PG8_SCHED;
            PG8_LDB(B1, 0, 1); PG8_STAGE(PG8_SB(0, 0), b2, voffB);
            PG8_BAR; PG8_WAIT_L(0); PG8_MMA(0, 1, At, B1); PG8_BAR;
            PG8_LDA(At, 0, 1); PG8_STAGE(PG8_SA(0, 0), a2, voffA);
            PG8_BAR; PG8_WAIT_L(0); PG8_MMA(1, 0, At, B0); PG8_BAR; PG8_SCHED;
            PG8_STAGE(PG8_SB(0, 1), b2 + hstepB, voffB);
            PG8_WAIT_V(6); PG8_BAR; PG8_MMA(1, 1, At, B1); PG8_BAR;
            PG8_LDB(B0, 1, 0); PG8_SCHED; PG8_LDA(At, 1, 0); PG8_STAGE(PG8_SA(0, 1), a2 + hstepA, voffA);
            PG8_WAIT_L(8); PG8_BAR; PG8_WAIT_L(0); PG8_MMA(0, 0, At, B0); PG8_BAR; PG8_SCHED;
            PG8_LDB(B1, 1, 1); PG8_STAGE(PG8_SB(1, 0), b3, voffB);
            PG8_BAR; PG8_WAIT_L(0); PG8_MMA(0, 1, At, B1); PG8_BAR;
            PG8_LDA(At, 1, 1); PG8_STAGE(PG8_SA(1, 0), a3, voffA);
            PG8_BAR; PG8_WAIT_L(0); PG8_MMA(1, 0, At, B0); PG8_BAR; PG8_SCHED;
            PG8_STAGE(PG8_SB(1, 1), b3 + hstepB, voffB);
            PG8_WAIT_V(6); PG8_BAR; PG8_MMA(1, 1, At, B1); PG8_BAR;
            }
        }
        if constexpr (ALIGN_EPI) { if (wr == 0) PG8_BAR; }
        if constexpr (!Epi::AFTER_DRAIN) { E(acc, cur, wr, wc, fr, fq); S.done(cur); }
        if (!has_next) break;
#pragma unroll
        for (int a = 0; a < 2; ++a)
#pragma unroll
            for (int b = 0; b < 2; ++b)
#pragma unroll
                for (int m = 0; m < 4; ++m)
#pragma unroll
                    for (int n = 0; n < 2; ++n) acc[a][b][m][n] = (f32x4){0.f, 0.f, 0.f, 0.f};
        cur = nxt; cA = nA; cB = nB; ++ui;
        if constexpr (ALIGN_EPI) { if (wr == 1) PG8_BAR; }
    }
    PG8_WAIT_V(0);
    if constexpr (!ALIGN_EPI) { if (wr == 0) PG8_BAR; }
    PG8_BAR;
    if constexpr (Epi::AFTER_DRAIN) { E.fused(acc, cur, wr, wc, fr, fq, lds, wid, lane); S.done(cur); }
#undef PG8_SA
#undef PG8_SB
#undef PG8_STAGE
#undef PG8_LDA
#undef PG8_LDB
#undef PG8_MMA
#undef PG8_WAIT_V
#undef PG8_WAIT_L
#undef PG8_BAR
#undef PG8_SCHED
}
}

namespace att {
typedef unsigned short bf16;
constexpr int   D = 128, NW = 8, QBLK = 32, KVBLK = 64;
constexpr float SCALE = 0.088388347648318440f;
constexpr float THR = 8.f;
constexpr int SDEPTH = 1;
constexpr int LDQ = 5120, LDK = 128, LDO = 2048;
constexpr size_t SHM_V = KVBLK * D * 2, SHM_K = KVBLK * D * 2, SHM_ATTN = 2 * SHM_V + 2 * SHM_K + NW * 64 * 4;
using bf16x8 = __attribute__((ext_vector_type(8))) short;
using s16x4  = __attribute__((ext_vector_type(4))) short;
using f32x16 = __attribute__((ext_vector_type(16))) float;
using f32x8  = __attribute__((ext_vector_type(8))) float;
using u32x4  = __attribute__((ext_vector_type(4))) unsigned;
#define KSWZ(row, colB) ((row) * 256 + ((colB) ^ (((row) & 15) << 4)))
#define SBAR() __builtin_amdgcn_sched_barrier(0)
__device__ __forceinline__ int crow(int r, int hi) { return (r & 3) + 8 * (r >> 2) + 4 * hi; }
__device__ __forceinline__ unsigned cvtpk(float lo, float hi) {
  unsigned r; asm volatile("v_cvt_pk_bf16_f32 %0, %1, %2" : "=v"(r) : "v"(lo), "v"(hi)); return r;
}
template <typename TIn> struct Stage;
template <> struct Stage<bf16>  { using T = bf16x8;
  __device__ static __forceinline__ T ld8(const bf16* p) { return *reinterpret_cast<const bf16x8*>(p); }
  __device__ static __forceinline__ bf16x8 tobf(T x) { return x; } };
template <> struct Stage<float> { using T = f32x8;
  __device__ static __forceinline__ T ld8(const float* p) { return *reinterpret_cast<const f32x8*>(p); }
  __device__ static __forceinline__ bf16x8 tobf(T x) {
    u32x4 w = {cvtpk(x[0], x[1]), cvtpk(x[2], x[3]), cvtpk(x[4], x[5]), cvtpk(x[6], x[7])}; return *reinterpret_cast<bf16x8*>(&w); } };

template <bool FAST>
__device__ __forceinline__ void partialSM(f32x16& p0, f32x16& p1, float& m_reg, float& mn, float& alpha) {
  if constexpr (FAST) {
    alpha = 1.f; mn = m_reg;
    for (int r = 0; r < 16; ++r) p0[r] = __builtin_amdgcn_exp2f(p0[r]);
    return;
  }
  constexpr float C = SCALE * 1.4426950408889634f;
  float pmax = p0[0]; for (int r = 1; r < 16; ++r) pmax = fmaxf(pmax, p0[r]); for (int r = 0; r < 16; ++r) pmax = fmaxf(pmax, p1[r]);
  { auto rr = __builtin_amdgcn_permlane32_swap(__float_as_uint(pmax), __float_as_uint(pmax), false, false);
    pmax = fmaxf(__uint_as_float(rr[0]), __uint_as_float(rr[1])); }
  if (__builtin_expect(__all(pmax - m_reg <= THR / SCALE), 1)) { mn = m_reg; alpha = 1.f; }
  else { mn = fmaxf(m_reg, pmax); alpha = __builtin_amdgcn_exp2f((m_reg - mn) * C); m_reg = mn; }
  float mnC = -mn * C;
  for (int r = 0; r < 16; ++r) p0[r] = fmaf(p0[r], C, mnC); for (int r = 0; r < 16; ++r) p1[r] = fmaf(p1[r], C, mnC);
  for (int r = 0; r < 16; ++r) p0[r] = __builtin_amdgcn_exp2f(p0[r]);
}
__device__ __forceinline__ void finishSM(f32x16& p0, f32x16& p1, float alpha, float& l_reg, bf16x8& pa0, bf16x8& pa1, bf16x8& pa2, bf16x8& pa3) {
  for (int r = 0; r < 16; ++r) p1[r] = __builtin_amdgcn_exp2f(p1[r]);
  float ps = 0; for (int r = 0; r < 16; ++r) ps += p0[r]; for (int r = 0; r < 16; ++r) ps += p1[r];
  { auto rr = __builtin_amdgcn_permlane32_swap(__float_as_uint(ps), __float_as_uint(ps), false, false);
    ps = __uint_as_float(rr[0]) + __uint_as_float(rr[1]); }
  l_reg = l_reg * alpha + ps;
#define PK4(P, BASE, OUT) do { unsigned a0 = cvtpk(P[BASE + 0], P[BASE + 1]), a1 = cvtpk(P[BASE + 2], P[BASE + 3]);   \
    unsigned b0 = cvtpk(P[BASE + 4], P[BASE + 5]), b1 = cvtpk(P[BASE + 6], P[BASE + 7]);                              \
    auto r0 = __builtin_amdgcn_permlane32_swap(a0, b0, false, false); auto r1 = __builtin_amdgcn_permlane32_swap(a1, b1, false, false); \
    u32x4 w = {r0[0], r1[0], r0[1], r1[1]}; OUT = *reinterpret_cast<bf16x8*>(&w); } while (0)
  PK4(p0, 0, pa0); PK4(p0, 8, pa1); PK4(p1, 0, pa2); PK4(p1, 8, pa3);
#undef PK4
}
__device__ __forceinline__ void qkt(f32x16& p0, f32x16& p1, const bf16* Ks, const bf16x8* qr, int r32, int hi, const float init) {
#define KLD(d0, row) (*reinterpret_cast<const bf16x8*>((const char*)Ks + KSWZ((row) + r32, ((d0) * 16 + hi * 8) * 2)))
  p0 = f32x16{}; p1 = f32x16{}; (void)init;
  bf16x8 a0 = KLD(0, 0), a1 = KLD(0, 32), b0 = KLD(1, 0), b1 = KLD(1, 32);
#pragma unroll
  for (int d0 = 0; d0 < 8; d0 += 2) {
    bf16x8 c0 = a0, c1 = a1, e0 = b0, e1 = b1;
    if (d0 + 2 < 8) { c0 = KLD(d0 + 2, 0); c1 = KLD(d0 + 2, 32); }
    p0 = __builtin_amdgcn_mfma_f32_32x32x16_bf16(a0, qr[d0], p0, 0, 0, 0);
    p1 = __builtin_amdgcn_mfma_f32_32x32x16_bf16(a1, qr[d0], p1, 0, 0, 0);
    if (d0 + 3 < 8) { e0 = KLD(d0 + 3, 0); e1 = KLD(d0 + 3, 32); }
    p0 = __builtin_amdgcn_mfma_f32_32x32x16_bf16(b0, qr[d0 + 1], p0, 0, 0, 0);
    p1 = __builtin_amdgcn_mfma_f32_32x32x16_bf16(b1, qr[d0 + 1], p1, 0, 0, 0);
    a0 = c0; a1 = c1; b0 = e0; b1 = e1;
  }
#undef KLD
}
__device__ __forceinline__ int v_st(int k, int c) { const int kk = (k & ~0xC) | ((k & 4) << 1) | ((k & 8) >> 1); return ((kk >> 3) * 4 + (c >> 5)) * 512 + ((kk & 7) * 32 + (c & 31)) * 2; }
__device__ __forceinline__ int v_rd_base(int lane) { return ((lane & 3) << 3) | (((lane >> 2) & 3) << 6) | (((lane >> 4) & 1) << 5) | (((lane >> 5) & 1) << 8); }
constexpr int v_rd_off(int d0, int ks, int half) { return d0 * 512 + ks * 4096 + half * 2048; }
template <int OFF> __device__ __forceinline__ s16x4 tr_read(int vb) {
  s16x4 r; asm volatile("ds_read_b64_tr_b16 %0, %1 offset:%2" : "=&v"(r) : "v"(vb), "i"(OFF) : "memory"); return r;
}
template <int D0> __device__ __forceinline__ void pv_one(f32x16& od, int vb, bf16x8 pa0, bf16x8 pa1, bf16x8 pa2, bf16x8 pa3) {
  const s16x4 l0 = tr_read<v_rd_off(D0, 0, 0)>(vb), h0 = tr_read<v_rd_off(D0, 0, 1)>(vb), l1 = tr_read<v_rd_off(D0, 1, 0)>(vb), h1 = tr_read<v_rd_off(D0, 1, 1)>(vb);
  const s16x4 l2 = tr_read<v_rd_off(D0, 2, 0)>(vb), h2 = tr_read<v_rd_off(D0, 2, 1)>(vb), l3 = tr_read<v_rd_off(D0, 3, 0)>(vb), h3 = tr_read<v_rd_off(D0, 3, 1)>(vb);
  asm volatile("s_waitcnt lgkmcnt(0)" ::: "memory"); SBAR();
#define PK(L, H) (bf16x8){L[0], L[1], L[2], L[3], H[0], H[1], H[2], H[3]}
  od = __builtin_amdgcn_mfma_f32_32x32x16_bf16(pa0, PK(l0, h0), od, 0, 0, 0);
  od = __builtin_amdgcn_mfma_f32_32x32x16_bf16(pa1, PK(l1, h1), od, 0, 0, 0);
  od = __builtin_amdgcn_mfma_f32_32x32x16_bf16(pa2, PK(l2, h2), od, 0, 0, 0);
  od = __builtin_amdgcn_mfma_f32_32x32x16_bf16(pa3, PK(l3, h3), od, 0, 0, 0);
#undef PK
}
__device__ __forceinline__ void pv_d0(f32x16* o, int vb, bf16x8 pa0, bf16x8 pa1, bf16x8 pa2, bf16x8 pa3) {
  pv_one<0>(o[0], vb, pa0, pa1, pa2, pa3); pv_one<1>(o[1], vb, pa0, pa1, pa2, pa3); pv_one<2>(o[2], vb, pa0, pa1, pa2, pa3); pv_one<3>(o[3], vb, pa0, pa1, pa2, pa3);
}

template <bool FAST>
__device__ __forceinline__ void attn_dense_body(const bf16* __restrict__ Qb, const bf16* __restrict__ Kh, const bf16* __restrict__ Vh,
                                                const bf16* __restrict__ Gb, bf16* __restrict__ Ob, const float* __restrict__ qg, const int t0, const float negBC, int seq, char* lds, const int wid, const int lane) {
  using TQ = bf16; using St = Stage<bf16>; using SQ = Stage<bf16>;
  const int tid = wid * 64 + lane, r32 = lane & 31, hi = lane >> 5;
  bf16* V_lds = (bf16*)lds; bf16* K_lds = (bf16*)(lds + 2 * SHM_V);
  float* ws = (float*)(lds + 2 * SHM_V + 2 * SHM_K) + wid * 64; float* li_l = ws; float* al_l = ws + 32;
  float m_reg = -1e30f, l_reg = 0; f32x16 o[4] = {}; bf16x8 qr[8];
  const bf16* Qw = Qb + (long)(wid * QBLK + r32) * LDQ + hi * 8;
  {
    bf16x8 raw[8]; float ss = 0.f;
#pragma unroll
    for (int d0 = 0; d0 < 8; ++d0) { raw[d0] = *reinterpret_cast<const bf16x8*>(Qw + d0 * 16);
#pragma unroll
      for (int j = 0; j < 8; ++j) { const float f = __uint_as_float((unsigned)(unsigned short)raw[d0][j] << 16); ss += f * f; } }
    { float a = ss, b = ss; asm volatile("s_nop 1\n\tv_permlane32_swap_b32 %0, %1\n\ts_nop 1" : "+v"(a), "+v"(b)); ss = a + b; }
    const float rstd = rsqrtf(ss * (1.f / 128.f) + 1e-6f);
    const int tq = t0 + wid * QBLK + r32; const float prow = (float)(tq >> 6), pcol = (float)(tq & 63);
#pragma unroll
    for (int d0 = 0; d0 < 8; ++d0) { const float pos = d0 < 4 ? prow : pcol;
      const float* gp = qg + d0 * 16 + hi * 8; const float g8[8] = {gp[0], gp[1], gp[2], gp[3], gp[4], gp[5], gp[6], gp[7]};
      float y[8];
#pragma unroll
      for (int j = 0; j < 8; ++j) y[j] = __uint_as_float((unsigned)(unsigned short)raw[d0][j] << 16) * rstd * g8[j] * (FAST ? SCALE * 1.4426950408889634f : 1.f);
      u32x4 w;
#pragma unroll
      for (int jj = 0; jj < 4; ++jj) { const int fi = (d0 & 3) * 8 + hi * 4 + jj;
        float xr = pos * exp2f(-(float)fi * (13.287712379549449f / 32.f)) * 0.15915494309189535f; xr -= floorf(xr);
        const float c = __builtin_amdgcn_cosf(xr), sn = __builtin_amdgcn_sinf(xr);
        w[jj] = cvtpk(y[2 * jj] * c - y[2 * jj + 1] * sn, y[2 * jj] * sn + y[2 * jj + 1] * c); }
      qr[d0] = *reinterpret_cast<bf16x8*>(&w); }
  }
  const int sr = tid >> 4, sc = (tid & 15) * 8, vst0 = v_st(sr, sc), vst1 = v_st(32 + sr, sc);
  const int vb0 = (int)(uintptr_t)V_lds + v_rd_base(lane);
  struct { typename St::T vs0, vs1, ks0, ks1; } sr_[SDEPTH];
#define SLOAD(i, k0) do { sr_[i].vs0 = St::ld8(&Vh[(long)((k0) + sr) * LDK + sc]); sr_[i].vs1 = St::ld8(&Vh[(long)((k0) + 32 + sr) * LDK + sc]); \
    sr_[i].ks0 = St::ld8(&Kh[(long)((k0) + sr) * LDK + sc]); sr_[i].ks1 = St::ld8(&Kh[(long)((k0) + 32 + sr) * LDK + sc]); } while (0)
#define SWRITE(b, i) do { *(bf16x8*)((char*)V_lds + (b) * SHM_V + vst0) = St::tobf(sr_[i].vs0);          \
    *(bf16x8*)((char*)V_lds + (b) * SHM_V + vst1) = St::tobf(sr_[i].vs1); int kc = sc * 2;               \
    *(bf16x8*)((char*)K_lds + (b) * SHM_K + KSWZ(sr, kc)) = St::tobf(sr_[i].ks0);                       \
    *(bf16x8*)((char*)K_lds + (b) * SHM_K + KSWZ(32 + sr, kc)) = St::tobf(sr_[i].ks1); } while (0)
#define SWAIT() do { if constexpr (SDEPTH == 2) asm volatile("s_waitcnt vmcnt(4)" ::: "memory"); else asm volatile("s_waitcnt vmcnt(0)" ::: "memory"); } while (0)
#define RESC(a) do { if (__any((a) < 1.f)) { if (hi == 0) al_l[r32] = (a); asm volatile("s_waitcnt lgkmcnt(0)" ::: "memory"); \
    for (int d = 0; d < 4; ++d) for (int r = 0; r < 16; ++r) o[d][r] *= al_l[crow(r, hi)]; } } while (0)
  f32x16 pA0, pA1, pB0, pB1; float mnA, mnB, alA, alB; bf16x8 pa0, pa1, pa2, pa3; const int NT = seq / KVBLK;
  constexpr int SE = 0, SO = SDEPTH - 1;
  SLOAD(SE, 0); asm volatile("s_waitcnt vmcnt(0)" ::: "memory"); SWRITE(0, SE); __syncthreads();
  const float sinit = FAST ? negBC : 0.f;
  qkt(pA0, pA1, K_lds, qr, r32, hi, sinit); partialSM<FAST>(pA0, pA1, m_reg, mnA, alA);
  SLOAD(SO, KVBLK); if constexpr (SDEPTH == 2) { if (2 < NT) SLOAD(SE, 2 * KVBLK); }
  SWAIT(); SWRITE(1, SO); __syncthreads();
#define STEP_LEAD(PN0, PN1, KB, PO0, PO1, ALO, LOADS, VB, MNN, ALN, WB, WSL) do { \
    SBAR(); qkt(PN0, PN1, KB, qr, r32, hi, sinit); finishSM(PO0, PO1, ALO, l_reg, pa0, pa1, pa2, pa3); SBAR(); LOADS; SBAR(); \
    pv_d0(o, VB, pa0, pa1, pa2, pa3); partialSM<FAST>(PN0, PN1, m_reg, MNN, ALN); \
    __syncthreads(); SWAIT(); SWRITE(WB, WSL); if constexpr (!FAST) RESC(ALN); __syncthreads(); } while (0)
#define STEP_TRAIL(PN0, PN1, KB, PO0, PO1, ALO, LOADS, VB, MNN, ALN, WB, WSL) do { \
    SBAR(); finishSM(PO0, PO1, ALO, l_reg, pa0, pa1, pa2, pa3); SBAR(); LOADS; SBAR(); qkt(PN0, PN1, KB, qr, r32, hi, sinit); SBAR(); \
    partialSM<FAST>(PN0, PN1, m_reg, MNN, ALN); SBAR(); pv_d0(o, VB, pa0, pa1, pa2, pa3); \
    __syncthreads(); SWAIT(); SWRITE(WB, WSL); if constexpr (!FAST) RESC(ALN); __syncthreads(); } while (0)
  bf16* const K1 = (bf16*)((char*)K_lds + SHM_K);
  if (wid < 8) {
    for (int j = 1; j + 1 < NT; j += 2) {
      STEP_LEAD(pB0, pB1, K1, pA0, pA1, alA, SLOAD(SO, (j + SDEPTH) * KVBLK), vb0, mnB, alB, 0, SE);
      STEP_LEAD(pA0, pA1, K_lds, pB0, pB1, alB, if (SDEPTH == 1 || j + 3 < NT) SLOAD(SE, (j + 1 + SDEPTH) * KVBLK), vb0 + (int)SHM_V, mnA, alA, 1, SO);
    }
  } else {
    for (int j = 1; j + 1 < NT; j += 2) {
      STEP_TRAIL(pB0, pB1, K1, pA0, pA1, alA, SLOAD(SO, (j + SDEPTH) * KVBLK), vb0, mnB, alB, 0, SE);
      STEP_TRAIL(pA0, pA1, K_lds, pB0, pB1, alB, if (SDEPTH == 1 || j + 3 < NT) SLOAD(SE, (j + 1 + SDEPTH) * KVBLK), vb0 + (int)SHM_V, mnA, alA, 1, SO);
    }
  }
#undef STEP_LEAD
#undef STEP_TRAIL
  SBAR(); qkt(pB0, pB1, (bf16*)((char*)K_lds + SHM_K), qr, r32, hi, sinit);
  finishSM(pA0, pA1, alA, l_reg, pa0, pa1, pa2, pa3); SBAR();
  pv_d0(o, vb0, pa0, pa1, pa2, pa3); partialSM<FAST>(pB0, pB1, m_reg, mnB, alB);
  __syncthreads(); if constexpr (!FAST) RESC(alB);
  finishSM(pB0, pB1, alB, l_reg, pa0, pa1, pa2, pa3); SBAR();
  pv_d0(o, vb0 + (int)SHM_V, pa0, pa1, pa2, pa3);
  if (hi == 0) li_l[r32] = l_reg; asm volatile("s_waitcnt lgkmcnt(0)" ::: "memory");
  float rli[16];
#pragma unroll
  for (int r = 0; r < 16; ++r) rli[r] = __builtin_amdgcn_rcpf(li_l[crow(r, hi)]);
  int lane_e = lane_id(); asm volatile("" : "+v"(lane_e)); const int r32e = lane_e & 31, hie = lane_e >> 5;
  bf16* Ow = Ob + (long)(wid * QBLK) * LDO; const bf16* Gw = Gb + (long)(wid * QBLK) * LDQ;
#pragma unroll
  for (int r = 0; r < 16; ++r) { int orow = crow(r, hie);
#pragma unroll
    for (int d0 = 0; d0 < 4; ++d0) { const float gt = __uint_as_float((unsigned)Gw[(long)orow * LDQ + d0 * 32 + r32e] << 16);
      const float sg = gt;
      Ow[(long)orow * LDO + d0 * 32 + r32e] = f2bf_rne(o[d0][r] * rli[r] * sg); } }
#undef SLOAD
#undef SWRITE
#undef SWAIT
#undef RESC
}
}

constexpr int DM = 2048, BATCH = 4, SEQ = 8192, MTOK = BATCH * SEQ;
constexpr int N_IN1 = 5120, N_IN2 = 4096;
constexpr int NTHR = 512, NWAVE = 8;
constexpr size_t MiB = 1u << 20;
constexpr size_t WS_BAR = 60 * MiB;
constexpr size_t WS_WT1 = 0, WS_WT2 = 20 * MiB, WS_WT3 = 28 * MiB, WS_WT4 = 44 * MiB, WS_DFTC = 52 * MiB, WS_MODP = 53 * MiB, WS_MOD = 59 * MiB;
constexpr size_t WS_W1 = 52 * MiB + 256 * 1024, WS_W2 = 52 * MiB + 512 * 1024;
constexpr size_t WS_TP = 64 * MiB;
constexpr size_t WS_H = 320 * MiB;
constexpr size_t WS_QKVG = 448 * MiB;
constexpr size_t WS_OG = 768 * MiB;
constexpr size_t WS_U = 448 * MiB, WS_SG = 576 * MiB, WS_UT = 768 * MiB, WS_Z = 320 * MiB, WS_FG = 768 * MiB;
constexpr size_t WS_KC = 896 * MiB, WS_VC = 928 * MiB;
constexpr size_t WS_X1 = 896 * MiB;
constexpr size_t WS_END = 1024 * MiB;
constexpr int LDS_BYTES = 131072 + 512 + 8192;
typedef unsigned short bf16;
typedef float f32x4 __attribute__((ext_vector_type(4)));
typedef unsigned u32x4 __attribute__((ext_vector_type(4)));
typedef unsigned u32x2 __attribute__((ext_vector_type(2)));
#define LDS_WAIT() asm volatile("s_waitcnt lgkmcnt(0)" ::: "memory")

template <int O> __device__ __forceinline__ float swz_xor(float v) { return __builtin_bit_cast(float, __builtin_amdgcn_ds_swizzle(__builtin_bit_cast(int, v), (O << 10) | 0x1f)); }
__device__ __forceinline__ float wave_sum(float v) {
    v += swz_xor<1>(v); v += swz_xor<2>(v); v += swz_xor<4>(v); v += swz_xor<8>(v); v += swz_xor<16>(v);
    float a = v, b = v;
    asm volatile("s_nop 1\n\tv_permlane32_swap_b32 %0, %1\n\ts_nop 1" : "+v"(a), "+v"(b));
    return a + b;
}
__device__ __forceinline__ unsigned pk2(float lo, float hi) { return (unsigned)f2bf_rne(lo) | ((unsigned)f2bf_rne(hi) << 16); }

__device__ __forceinline__ void transpose_item(const float* W, int K, int N, bf16* WT, float* scr, int item, int lane) {
    const int nblk = N / 32, kb = item / nblk, nb = item % nblk, k0 = 64 * kb, n0 = 32 * nb;
#pragma unroll 8
    for (int i = 0; i < 32; ++i) { const int kk = 2 * i + (lane >> 5); scr[kk * 33 + (lane & 31)] = W[(size_t)(k0 + kk) * N + n0 + (lane & 31)]; }
    LDS_WAIT(); asm volatile("" ::: "memory");
    const int c = lane & 7;
#pragma unroll
    for (int j = 0; j < 4; ++j) { const int n = (lane >> 3) + 8 * j; const float* s = scr + (8 * c) * 33 + n;
        u32x4 o; o.x = pk2(s[0 * 33], s[1 * 33]); o.y = pk2(s[2 * 33], s[3 * 33]); o.z = pk2(s[4 * 33], s[5 * 33]); o.w = pk2(s[6 * 33], s[7 * 33]);
        *(u32x4*)(WT + (size_t)(n0 + n) * K + k0 + 8 * c) = o; }
    LDS_WAIT(); asm volatile("" ::: "memory");
}

__device__ __forceinline__ void mod_partial_item(const float* cvec, const float* ada_w, float* modp, int item, int lane) {
    const int l = item / 768, rem = item % 768, kc = rem / 24, cc = rem % 24, k0 = kc * 64, col0 = cc * 256 + lane * 4;
    float sc0 = silu_f(cvec[0 * DM + k0 + lane]), sc1 = silu_f(cvec[1 * DM + k0 + lane]), sc2 = silu_f(cvec[2 * DM + k0 + lane]), sc3 = silu_f(cvec[3 * DM + k0 + lane]);
    f32x4 a0 = {0.f, 0.f, 0.f, 0.f}, a1 = a0, a2 = a0, a3 = a0;
    const float* wp = ada_w + ((size_t)l * DM + k0) * 6144 + col0;
#pragma unroll 8
    for (int kk = 0; kk < 64; ++kk) { const f32x4 w = *(const f32x4*)(wp + (size_t)kk * 6144);
        const float s0 = __builtin_bit_cast(float, __builtin_amdgcn_readlane(__builtin_bit_cast(int, sc0), kk));
        const float s1 = __builtin_bit_cast(float, __builtin_amdgcn_readlane(__builtin_bit_cast(int, sc1), kk));
        const float s2 = __builtin_bit_cast(float, __builtin_amdgcn_readlane(__builtin_bit_cast(int, sc2), kk));
        const float s3 = __builtin_bit_cast(float, __builtin_amdgcn_readlane(__builtin_bit_cast(int, sc3), kk));
        a0 += w * s0; a1 += w * s1; a2 += w * s2; a3 += w * s3; }
    float* o = modp + (size_t)((kc * 2 + l) * 4) * 6144 + col0;
    *(f32x4*)(o) = a0; *(f32x4*)(o + 6144) = a1; *(f32x4*)(o + 2 * 6144) = a2; *(f32x4*)(o + 3 * 6144) = a3;
}

__device__ __forceinline__ f32x4 ld4f(const float* p) { return *(const f32x4*)p; }
__device__ __forceinline__ f32x4 ld4f(const bf16* p) { const u32x2 w = *(const u32x2*)p; return (f32x4){__builtin_bit_cast(float, w.x << 16), __builtin_bit_cast(float, w.x & 0xffff0000u), __builtin_bit_cast(float, w.y << 16), __builtin_bit_cast(float, w.y & 0xffff0000u)}; }
template <typename TX, bool PERMUTE>
__device__ __forceinline__ void norm_mod_rows(const TX* x, const float* g, const float* modl  , bf16* H, int gw, int ngw, int lane) {
    for (int row0 = gw * 16; row0 < MTOK; row0 += ngw * 16) {
        const int b = row0 / SEQ; const float* mb = modl + (size_t)b * 6144;
        f32x4 ca[8], cs[8];
#pragma unroll
        for (int j = 0; j < 8; ++j) { const int c = lane * 4 + 256 * j; const f32x4 gg = *(const f32x4*)(g + c), scv = *(const f32x4*)(mb + 2048 + c);
            ca[j] = gg * (scv + 1.0f); cs[j] = *(const f32x4*)(mb + c); }
        for (int rr = 0; rr < 16; ++rr) { const int row = row0 + rr, tt = row & (SEQ - 1); const size_t ro = (size_t)row * DM;
            const size_t wo = PERMUTE ? (size_t)((row - tt) + (tt & 63) * 128 + (tt >> 6)) * DM : ro;
            f32x4 v[8]; float ss = 0.f;
#pragma unroll
            for (int j = 0; j < 8; ++j) { v[j] = ld4f(x + ro + lane * 4 + 256 * j); ss += (v[j].x * v[j].x + v[j].y * v[j].y) + (v[j].z * v[j].z + v[j].w * v[j].w); }
            const float rstd = rsqrtf(wave_sum(ss) * (1.f / DM) + 1e-6f);
#pragma unroll
            for (int j = 0; j < 8; ++j) { const f32x4 y = v[j] * rstd * ca[j] + cs[j]; u32x2 w; w.x = pk2(y.x, y.y); w.y = pk2(y.z, y.w);
                *(u32x2*)(H + wo + lane * 4 + 256 * j) = w; } }
    }
}

__device__ __forceinline__ void k_norm_rope_rows(const bf16* P, bf16* KC, bf16* VC, const float* kg, int gw, int ngw, int lane) {
    const int l16 = lane & 15, kvh = lane >> 4;
    float gk[8], invf[4];
#pragma unroll
    for (int i = 0; i < 8; ++i) gk[i] = kg[l16 * 8 + i];
#pragma unroll
    for (int i = 0; i < 4; ++i) { const int j = (l16 * 4 + i) & 31; invf[i] = exp2f(-(float)j * (13.287712379549449f / 32.f)); }
    for (int row0 = gw * 16; row0 < MTOK; row0 += ngw * 16) {
#pragma unroll 4
        for (int rr = 0; rr < 16; ++rr) { const int row = row0 + rr, t = row & (SEQ - 1), bb = row >> 13;
            const float pos = (float)((l16 < 8) ? (t >> 6) : (t & 63));
            const bf16* rp = P + (size_t)row * 5120 + 2048 + lane * 8;
            const u32x4 w = *(const u32x4*)rp; const u32x4 vv = *(const u32x4*)(rp + 512);
            float cs[4], sn[4];
#pragma unroll
            for (int i = 0; i < 4; ++i) { float xr = pos * invf[i] * 0.15915494309189535f; xr -= floorf(xr); cs[i] = __builtin_amdgcn_cosf(xr); sn[i] = __builtin_amdgcn_sinf(xr); }
            float v[8] = {bf2f((bf16)(w.x & 0xffff)), bf2f((bf16)(w.x >> 16)), bf2f((bf16)(w.y & 0xffff)), bf2f((bf16)(w.y >> 16)),
                          bf2f((bf16)(w.z & 0xffff)), bf2f((bf16)(w.z >> 16)), bf2f((bf16)(w.w & 0xffff)), bf2f((bf16)(w.w >> 16))};
            float ss = 0.f;
#pragma unroll
            for (int i = 0; i < 8; ++i) ss += v[i] * v[i];
            ss += swz_xor<1>(ss); ss += swz_xor<2>(ss); ss += swz_xor<4>(ss); ss += swz_xor<8>(ss);
            const float rstd = rsqrtf(ss * (1.f / 128.f) + 1e-6f);
            float y[8];
#pragma unroll
            for (int i = 0; i < 8; ++i) y[i] = v[i] * rstd * gk[i];
            u32x4 o;
            o.x = pk2(y[0] * cs[0] - y[1] * sn[0], y[0] * sn[0] + y[1] * cs[0]);
            o.y = pk2(y[2] * cs[1] - y[3] * sn[1], y[2] * sn[1] + y[3] * cs[1]);
            o.z = pk2(y[4] * cs[2] - y[5] * sn[2], y[4] * sn[2] + y[5] * cs[2]);
            o.w = pk2(y[6] * cs[3] - y[7] * sn[3], y[6] * sn[3] + y[7] * cs[3]);
            const size_t co = (((size_t)(bb * 4 + kvh)) * SEQ + t) * 128 + l16 * 8;
            *(u32x4*)(KC + co) = o; *(u32x4*)(VC + co) = vv; }
    }
}

__device__ __forceinline__ void transpose_u_block(const bf16* U, bf16* UT, unsigned short* lt, int id, int tid) {
    const int ct = id & 31, n2g = (id >> 5) & 15, b = id >> 9;
#pragma unroll
    for (int i = 0; i < 8; ++i) { const int q = tid + 512 * i, row = q >> 3, ch = q & 7, n2l = row >> 7, n1 = row & 127, n = n1 * 64 + n2g * 4 + n2l;
        const u32x4 w = *(const u32x4*)(U + ((size_t)(b * SEQ + n)) * DM + ct * 64 + ch * 8);
        unsigned short* d = lt + (ch * 8) * 512 + ((((row >> 3) ^ ch) << 3) | (row & 7));
        d[0] = (unsigned short)(w.x & 0xffff); d[512] = (unsigned short)(w.x >> 16); d[1024] = (unsigned short)(w.y & 0xffff); d[1536] = (unsigned short)(w.y >> 16);
        d[2048] = (unsigned short)(w.z & 0xffff); d[2560] = (unsigned short)(w.z >> 16); d[3072] = (unsigned short)(w.w & 0xffff); d[3584] = (unsigned short)(w.w >> 16); }
    __syncthreads();
#pragma unroll
    for (int i = 0; i < 8; ++i) { const int o = tid + 512 * i, n1c = o & 15, n2l = (o >> 4) & 3, c = o >> 6, gi = n2l * 16 + n1c;
        const u32x4 w = *(const u32x4*)(lt + c * 512 + ((gi ^ ((c >> 3) & 7)) << 3));
        *(u32x4*)(UT + (((size_t)(b * DM + ct * 64 + c)) * 64 + n2g * 4 + n2l) * 128 + n1c * 8) = w; }
    __syncthreads();
}

#define XB_TMO      128
#define XB_XCNT(j)  (256  + 64 * (j))
#define XB_XSUB(j)  (1280 + 64 * (j))
#define XB_XGEN(j)  (2304 + 64 * (j))
#define XB_TOP      3328
#define XB_TOPGEN   3392
#define XCD_BAR_WORDS 3456
#define XB_SPIN_CAP (1u << 18)

__device__ __forceinline__ unsigned xb_ld(unsigned* p)              { return __hip_atomic_load(p, __ATOMIC_RELAXED, __HIP_MEMORY_SCOPE_AGENT); }
__device__ __forceinline__ unsigned xb_add(unsigned* p, unsigned v) { return __hip_atomic_fetch_add(p, v, __ATOMIC_RELAXED, __HIP_MEMORY_SCOPE_AGENT); }
__device__ __forceinline__ unsigned xb_xcc_id() { return (unsigned)__builtin_amdgcn_s_getreg((3 << 11) | 20) & 0xFu; }
#define XB_SPIN(cond, bar) do { unsigned _sp = 0; while (cond) { __builtin_amdgcn_s_sleep(1); \
    if ((++_sp & 255u) == 0u) { if (xb_ld(&(bar)[XB_TMO])) break; if (_sp > XB_SPIN_CAP) { atomicAdd(&(bar)[XB_TMO], 1u); break; } } } } while (0)

struct XcdBarrier {
    unsigned* bar; unsigned x;
    volatile __attribute__((address_space(3))) unsigned* st;
};

__device__ __forceinline__ XcdBarrier xcd_barrier_post(unsigned* bar, volatile __attribute__((address_space(3))) unsigned* st, const bool t0) {
    XcdBarrier b; b.bar = bar; b.x = xb_xcc_id(); b.st = st;
    if (t0) (void)xb_add(&bar[XB_XCNT(b.x)], 1u);
    return b;
}
__device__ __forceinline__ void xcd_barrier_complete(unsigned* bar, unsigned x, unsigned& nloc, unsigned& nx) {
    const unsigned G = gridDim.x * gridDim.y * gridDim.z;
    unsigned sum, cnt, mine, sp = 0u;
    for (;;) {
        sum = 0u; cnt = 0u; mine = 0u;
#pragma unroll
        for (unsigned j = 0; j < 16; ++j) { const unsigned c = xb_ld(&bar[XB_XCNT(j)]); sum += c; cnt += (c > 0u) ? 1u : 0u; mine = (j == x) ? c : mine; }
        if (sum == G) break;
        __builtin_amdgcn_s_sleep(1);
        if ((++sp & 255u) == 0u) { if (xb_ld(&bar[XB_TMO])) break; if (sp > XB_SPIN_CAP) { atomicAdd(&bar[XB_TMO], 1u); break; } }
    }
    nloc = mine > 0u ? mine : 1u; nx = cnt > 0u ? cnt : 1u;
}

__device__ __forceinline__ void xcd_barrier(const XcdBarrier& b, const bool t0) {
    asm volatile("s_waitcnt vmcnt(0)" ::: "memory");
    __syncthreads();
    if (t0) {
        unsigned* bar = b.bar;
        __builtin_amdgcn_s_waitcnt(0);
        unsigned nloc = b.st[0], nx = b.st[1];
        if (nloc == 0u) { xcd_barrier_complete(bar, b.x, nloc, nx); b.st[0] = nloc; b.st[1] = nx; }
        const unsigned old = xb_add(&bar[XB_XSUB(b.x)], 1u);
        const unsigned gen = old / nloc;
        if (old + 1u == (gen + 1u) * nloc) {
            __builtin_amdgcn_fence(__ATOMIC_RELEASE, "agent");
            asm volatile("s_waitcnt vmcnt(0)" ::: "memory");
            const unsigned og = xb_add(&bar[XB_TOP], 1u);
            const unsigned tg = og / nx;
            if (og + 1u == (tg + 1u) * nx) xb_add(&bar[XB_TOPGEN], 1u);
            else XB_SPIN(xb_ld(&bar[XB_TOPGEN]) == tg, bar);
            __builtin_amdgcn_fence(__ATOMIC_ACQUIRE, "agent");
            xb_add(&bar[XB_XGEN(b.x)], 1u);
            asm volatile("s_waitcnt vmcnt(0)" ::: "memory");
        } else {
            XB_SPIN(xb_ld(&bar[XB_XGEN(b.x)]) == gen, bar);
            __builtin_amdgcn_fence(__ATOMIC_ACQUIRE, "agent");
            asm volatile("s_waitcnt vmcnt(0)" ::: "memory");
        }
    }
    __syncthreads();
}

struct Args { const float* in[12]; float* out; unsigned char* ws; };

__global__ void __launch_bounds__(NTHR, 2) fwd_megakernel(Args args) {
    extern __shared__ __attribute__((aligned(16))) unsigned char lds[];
    cg::grid_group grid = cg::this_grid();
    const int G = gridDim.x, bx = blockIdx.x;
    const int wave_s = __builtin_amdgcn_readfirstlane((int)threadIdx.x >> 6);
    const int NGW = G * NWAVE; const long NGT = (long)G * NTHR;
#define PHASE_IDS() int lane_p = lane_id(); asm volatile("" : "+v"(lane_p)); const int lane = lane_p, wave = wave_s, tid = wave * 64 + lane; (void)tid; \
    const int gw = bx * NWAVE + wave; const long gt = (long)bx * NTHR + tid; (void)lane; (void)gw; (void)gt;
    typedef const float* cfptr_t; typedef float* fptr_t; typedef unsigned char* ucptr_t;
#define KA4 __attribute__((address_space(4)))
#define PTRS() const KA4 unsigned char* ka_ = (const KA4 unsigned char*)__builtin_amdgcn_kernarg_segment_ptr(); asm volatile("" : "+s"(ka_)); \
    const float* x = *(const KA4 cfptr_t*)(ka_ + 0); const float* cvec = *(const KA4 cfptr_t*)(ka_ + 8); const float* norm_g = *(const KA4 cfptr_t*)(ka_ + 16); \
    const float* ada_w = *(const KA4 cfptr_t*)(ka_ + 24); const float* ada_b = *(const KA4 cfptr_t*)(ka_ + 32); const float* attn_w_in = *(const KA4 cfptr_t*)(ka_ + 40); \
    const float* q_gain = *(const KA4 cfptr_t*)(ka_ + 48); const float* k_gain = *(const KA4 cfptr_t*)(ka_ + 56); const float* attn_w_out = *(const KA4 cfptr_t*)(ka_ + 64); \
    const float* f_w_in = *(const KA4 cfptr_t*)(ka_ + 72); const float* f_w_out = *(const KA4 cfptr_t*)(ka_ + 80); const float* final_g = *(const KA4 cfptr_t*)(ka_ + 88); \
    float* out = *(const KA4 fptr_t*)(ka_ + 96); unsigned char* ws = *(const KA4 ucptr_t*)(ka_ + 104); \
    bf16* WT1 = (bf16*)(ws + WS_WT1); bf16* WT2 = (bf16*)(ws + WS_WT2); bf16* WT3 = (bf16*)(ws + WS_WT3); bf16* WT4 = (bf16*)(ws + WS_WT4); \
    bf16* DFTC = (bf16*)(ws + WS_DFTC); bf16* FW1 = (bf16*)(ws + WS_W1); bf16* FW2 = (bf16*)(ws + WS_W2); bf16* TP = (bf16*)(ws + WS_TP); \
    float* MODP = (float*)(ws + WS_MODP); float* MOD = (float*)(ws + WS_MOD); bf16* KC = (bf16*)(ws + WS_KC); bf16* VC = (bf16*)(ws + WS_VC); bf16* X1 = (bf16*)(ws + WS_X1); (void)X1; \
    bf16* H = (bf16*)(ws + WS_H); bf16* QKVG = (bf16*)(ws + WS_QKVG); bf16* OG = (bf16*)(ws + WS_OG); \
    bf16* U = (bf16*)(ws + WS_U); bf16* SG = (bf16*)(ws + WS_SG); bf16* UT = (bf16*)(ws + WS_UT); bf16* Z = (bf16*)(ws + WS_Z); bf16* FG = (bf16*)(ws + WS_FG); \
    (void)x; (void)cvec; (void)norm_g; (void)ada_w; (void)ada_b; (void)attn_w_in; (void)q_gain; (void)k_gain; (void)attn_w_out; (void)f_w_in; (void)f_w_out; (void)final_g; (void)out; \
    (void)WT1; (void)WT2; (void)WT3; (void)WT4; (void)DFTC; (void)FW1; (void)FW2; (void)TP; (void)MODP; (void)MOD; (void)KC; (void)VC; (void)H; (void)QKVG; (void)OG; (void)U; (void)SG; (void)UT; (void)Z; (void)FG;
    __attribute__((address_space(3))) unsigned char* lds3 = (__attribute__((address_space(3))) unsigned char*)lds;
    volatile __attribute__((address_space(3))) unsigned* bar_st = (volatile __attribute__((address_space(3))) unsigned*)(lds3 + 131072 + 32);
    { PHASE_IDS(); if (tid < 64) ((volatile __attribute__((address_space(3))) unsigned*)(lds3 + 131072))[tid] = 0u; __syncthreads(); }

    {
        PHASE_IDS(); PTRS();
        if (bx == 0) { unsigned* bw = (unsigned*)(ws + WS_BAR); for (int i = tid; i < XCD_BAR_WORDS; i += NTHR) bw[i] = 0u; }
        float* scr = (float*)(lds + wave * 16384);
        constexpr int I1 = (DM / 64) * (N_IN1 / 32), I2 = (DM / 64) * (DM / 32), I3 = (DM / 64) * (N_IN2 / 32), I4 = I2, IM = 1536;
        for (int it = gw; it < IM + I1 + I2 + I3 + I4; it += NGW) {
            int r = it;
            if (r < IM) { mod_partial_item(cvec, ada_w, MODP, r, lane); continue; } r -= IM;
            if (r < I1) { transpose_item(attn_w_in, DM, N_IN1, WT1, scr, r, lane); continue; } r -= I1;
            if (r < I2) { transpose_item(attn_w_out, DM, DM, WT2, scr, r, lane); continue; } r -= I2;
            if (r < I3) { transpose_item(f_w_in, DM, N_IN2, WT3, scr, r, lane); continue; } r -= I3;
            transpose_item(f_w_out, DM, DM, WT4, scr, r, lane);
        }
        for (long i = gt; i < 256 * 128; i += NGT) { const int r = (int)(i >> 7), n1 = (int)(i & 127), ri = r >> 7, k1 = r & 127;
            const float xr = (float)((n1 * k1) & 127) * (1.f / 128.f);
            FW1[i] = f2bf_rne(ri ? -__builtin_amdgcn_sinf(xr) : __builtin_amdgcn_cosf(xr)); }
        for (long i = gt; i < 256 * 128; i += NGT) { const int r = (int)(i >> 7), j = (int)(i & 127), ro = (r >> 6) & 1, k2 = r & 63, ri = j >> 6, n2 = j & 63;
            const float xr = (float)((n2 * k2) & 63) * (1.f / 64.f); const float cv = __builtin_amdgcn_cosf(xr), sv = __builtin_amdgcn_sinf(xr);
            const float v = (ro == ri) ? cv : (ro == 0 ? sv : -sv);
            FW2[i] = f2bf_rne(r < 128 ? v : 0.f); }
        for (long i = gt; i < 256 * 512; i += NGT) { const int kc = (int)(i >> 9), j = (int)(i & 511), c = j & 255;
            const float xr = (float)((kc * c) & 255) * (1.f / 256.f);
            DFTC[i] = f2bf_rne(j < 256 ? __builtin_amdgcn_cosf(xr) : __builtin_amdgcn_sinf(xr)); }
    }
    grid.sync();
    XcdBarrier xbar;
    { PHASE_IDS(); PTRS(); xbar = xcd_barrier_post((unsigned*)(ws + WS_BAR), bar_st, tid == 0); }
#define GRID_BAR() do { int l_ = lane_id(); asm volatile("" : "+v"(l_)); xcd_barrier(xbar, (wave_s == 0) & (l_ == 0)); } while (0)
    { PHASE_IDS(); PTRS();
    for (long i = gt; i < 2 * 4 * 6144; i += NGT) { const int j = (int)(i % 6144), lb = (int)(i / 6144), l = lb >> 2;
        float s = ada_b[l * 6144 + j];
        for (int kc = 0; kc < 32; ++kc) s += MODP[(size_t)(kc * 8 + lb) * 6144 + j];
        MOD[i] = s; }
      if (gt == 0) { float mq = 0.f, mk = 0.f; for (int i = 0; i < 128; ++i) { mq = fmaxf(mq, fabsf(q_gain[i])); mk = fmaxf(mk, fabsf(k_gain[i])); } MOD[49152] = 128.f * mq * mk * 1.01f; } }
    GRID_BAR();
    { PHASE_IDS(); PTRS(); norm_mod_rows<float, false>(x, norm_g, MOD, H, gw, NGW, lane); }
    GRID_BAR();
    {
        PTRS();
        pg8::Gemm g{H, WT1, DM, DM, DM, 0, (size_t)256 * DM * 2}; pg8::StaticOrder S; S.init(MTOK, N_IN1, G, bx);
        pg8::EpiQKVG E{QKVG, KC, VC, k_gain, (__attribute__((address_space(3))) float*)(lds3 + 131072 + 512)};
        pg8::gemm_phase<pg8::EpiQKVG, pg8::StaticOrder, true, true>(lds3, g, S, E, wave_s);
    }
    GRID_BAR();
    {
        PTRS();
        constexpr int NUNITS = BATCH * 16 * (SEQ / 256);
        const float Braw = MOD[49152]; const bool fast = Braw * att::SCALE <= 40.f; const float negBC = -Braw * att::SCALE * 1.4426950408889634f;
        if (fast) {
        for (int i = 0; i * G + bx < NUNITS; ++i) {
            int b, h, qb;
            if (G == 256) { const int xc = bx & 7, j = bx >> 3, pair = 2 * xc + (i >> 2); b = pair >> 2; h = (pair & 3) * 4 + (i & 3); qb = j; }
            else { const int uu = i * G + bx; qb = uu & 31; h = (uu >> 5) & 15; b = uu >> 9; }
            const int kvh = h >> 2; int lane_a = lane_id(); asm volatile("" : "+v"(lane_a));
            const size_t qrow = (size_t)(b * SEQ + qb * 256) * 5120, kvo = ((size_t)(b * 4 + kvh)) * SEQ * 128;
att::attn_dense_body<true>(QKVG + qrow + h * 128, KC + kvo, VC + kvo, QKVG + qrow + 3072 + h * 128,
                                 OG + (size_t)(b * SEQ + qb * 256) * 2048 + h * 128, q_gain, qb * 256, negBC, SEQ, (char*)lds, wave_s, lane_a);
            __syncthreads();
        }
        } else {
        for (int i = 0; i * G + bx < NUNITS; ++i) {
            int b, h, qb;
            if (G == 256) { const int xc = bx & 7, j = bx >> 3, pair = 2 * xc + (i >> 2); b = pair >> 2; h = (pair & 3) * 4 + (i & 3); qb = j; }
            else { const int uu = i * G + bx; qb = uu & 31; h = (uu >> 5) & 15; b = uu >> 9; }
            const int kvh = h >> 2; int lane_a = lane_id(); asm volatile("" : "+v"(lane_a));
            const size_t qrow = (size_t)(b * SEQ + qb * 256) * 5120, kvo = ((size_t)(b * 4 + kvh)) * SEQ * 128;
att::attn_dense_body<false>(QKVG + qrow + h * 128, KC + kvo, VC + kvo, QKVG + qrow + 3072 + h * 128,
                                 OG + (size_t)(b * SEQ + qb * 256) * 2048 + h * 128, q_gain, qb * 256, 0.f, SEQ, (char*)lds, wave_s, lane_a);
            __syncthreads();
        }
        }
    }
    GRID_BAR();
    {
        PTRS();
        pg8::Gemm g{OG, WT2, DM, DM, DM, 0, (size_t)256 * DM * 2}; pg8::StaticOrder S; S.init(MTOK, DM, G, bx);
        pg8::EpiResid1 E{x, X1, MOD + 4096};
        pg8::gemm_phase<pg8::EpiResid1, pg8::StaticOrder, true, true>(lds3, g, S, E, wave_s);
    }
    GRID_BAR();
    { PHASE_IDS(); PTRS(); norm_mod_rows<bf16, true>(X1, norm_g + DM, MOD + 4 * 6144, H, gw, NGW, lane); }
    GRID_BAR();
    {
        PTRS();
        static_assert(WS_WT3 == 28 * MiB && WS_H == 320 * MiB && (size_t)256 * DM * 2 == MiB, "virtual tile indices of the DualOrder stream");
        pg8::Gemm g{(const bf16*)ws, (const bf16*)ws, DM, DM, DM, 0, (size_t)256 * DM * 2};
        pg8::DualOrder S; S.init(DM, MTOK, MTOK, DM, G, bx, 28, 320, 320, 36);
        pg8::EpiUTSG E{{UT}, {SG}};
        pg8::gemm_phase<pg8::EpiUTSG, pg8::DualOrder, true, true>(lds3, g, S, E, wave_s);
    }
    GRID_BAR();
    {
        PTRS();
        pg8::Gemm g{FW1, UT, 128, 128, 128, 0, (size_t)256 * 128 * 2}; pg8::StaticOrder S; S.init(256, BATCH * DM * 64, G, bx);
        pg8::EpiFft1 E{TP};
        pg8::gemm_phase<pg8::EpiFft1, pg8::StaticOrder, true, true>(lds3, g, S, E, wave_s);
    }
    GRID_BAR();
    {
        PTRS();
        pg8::Gemm g{FW2, TP, 128, 128, 128, 0, (size_t)256 * 128 * 2}; pg8::StaticOrder S; S.init(256, BATCH * 128 * DM, G, bx);
        pg8::EpiFft2 E{Z};
        pg8::gemm_phase<pg8::EpiFft2, pg8::StaticOrder, true, true>(lds3, g, S, E, wave_s);
    }
    GRID_BAR();
    {
        PTRS();
        pg8::Gemm g{Z, DFTC, 4096, 512, 512, (size_t)512 * 2, 0}; pg8::StaticOrder S; S.init(MTOK, DM, G, bx);
        pg8::EpiDftC E{SG, FG, 6.9053396600248786e-4f};
        pg8::gemm_phase<pg8::EpiDftC, pg8::StaticOrder, true, true>(lds3, g, S, E, wave_s);
    }
    GRID_BAR();
    {
        PTRS();
        pg8::Gemm g{FG, WT4, DM, DM, DM, 0, (size_t)256 * DM * 2}; pg8::StaticOrder S; S.init(MTOK, DM, G, bx);
        pg8::EpiResid2 E{X1, MOD + 4 * 6144 + 4096};
        pg8::gemm_phase<pg8::EpiResid2, pg8::StaticOrder, true, true>(lds3, g, S, E, wave_s);
    }
    GRID_BAR();
    { PHASE_IDS(); PTRS();
    for (int row = gw; row < MTOK; row += NGW) { float* rp = out + (size_t)row * DM + lane * 4; const bf16* xp = X1 + (size_t)row * DM + lane * 4;
        f32x4 v[8]; float ss = 0.f;
#pragma unroll
        for (int j = 0; j < 8; ++j) { v[j] = ld4f(xp + 256 * j); ss += (v[j].x * v[j].x + v[j].y * v[j].y) + (v[j].z * v[j].z + v[j].w * v[j].w); }
        const float rstd = rsqrtf(wave_sum(ss) * (1.f / DM) + 1e-6f);
#pragma unroll
        for (int j = 0; j < 8; ++j) *(f32x4*)(rp + 256 * j) = v[j] * rstd * *(const f32x4*)(final_g + lane * 4 + 256 * j); } }
}

extern "C" void kernel_launch(void* const* d_in, const int* in_sizes, int n_in, void* d_out, int out_size, void* d_ws, size_t ws_size, hipStream_t stream) {
    static int grid_blocks = 0;
    if (grid_blocks == 0) {
        if (n_in != 12 || in_sizes[0] != MTOK * DM || out_size != MTOK * DM || ws_size < WS_END) {
            fprintf(stderr, "kernel_launch: shape mismatch n_in %d in0 %d out %d ws %zu (need %zu)\n", n_in, n_in > 0 ? in_sizes[0] : -1, out_size, ws_size, (size_t)WS_END); grid_blocks = -1; return; }
        int dev = 0, cus = 0, per_cu = 0;
        hipGetDevice(&dev);
        hipDeviceGetAttribute(&cus, hipDeviceAttributeMultiprocessorCount, dev);
        if (hipFuncSetAttribute((const void*)fwd_megakernel, hipFuncAttributeMaxDynamicSharedMemorySize, LDS_BYTES) != hipSuccess) { fprintf(stderr, "kernel_launch: hipFuncSetAttribute failed\n"); grid_blocks = -1; return; }
        if (hipOccupancyMaxActiveBlocksPerMultiprocessor(&per_cu, (const void*)fwd_megakernel, NTHR, LDS_BYTES) != hipSuccess || per_cu < 1) { fprintf(stderr, "kernel_launch: occupancy query gave %d\n", per_cu); per_cu = 1; }
        (void)hipGetLastError();
        grid_blocks = cus * per_cu;
    }
    if (grid_blocks < 0) return;
    Args a{};
    for (int i = 0; i < 12; ++i) a.in[i] = (const float*)d_in[i];
    a.out = (float*)d_out; a.ws = (unsigned char*)d_ws;
    void* kargs[] = {&a};
    hipError_t e = hipLaunchCooperativeKernel((const void*)fwd_megakernel, dim3(grid_blocks), dim3(NTHR), kargs, LDS_BYTES, stream);
    if (e != hipSuccess) fprintf(stderr, "cooperative launch failed: %s (grid %d)\n", hipGetErrorString(e), grid_blocks);
}
```
